# Optimizing an MI355X kernel written in HIP

```python
import jax, jax.numpy as jnp
from jax import lax
import numpy as np

D_MODEL = 1024
BATCH = 16
SEQ = 2048
DEPTH = 2

N_MIXERS = 2
HEAD_DIM = 64
N_HEADS = D_MODEL // HEAD_DIM
DILATED_GROUPS = ((128, 1), (512, 4), (2048, 16))
N_GROUPS = len(DILATED_GROUPS)
ROPE_THETA = 500000.0
ROPE_DIM = HEAD_DIM // 4
BLK = 64
CONV_WIDTH = 3
FFN_HIDDEN = -(-8 * D_MODEL // (3 * 256)) * 256
NORM_EPS = 1e-6
NEG_INF = -1e30

kernel_name = "hybrid_dilated_attn_shortconv_adaln_encoder"


def rms_norm(x, g):
    xf = x.astype(jnp.float32)
    r = lax.rsqrt(jnp.mean(xf * xf, axis=-1, keepdims=True) + NORM_EPS)
    return (xf * r).astype(x.dtype) * g


def modulate(h, shift, scale):
    return h * (1 + scale) + shift


def rope_partial(x, pos):
    half = ROPE_DIM // 2
    inv = ROPE_THETA ** (-jnp.arange(half, dtype=jnp.float32) * (2.0 / ROPE_DIM))
    ang = pos.astype(jnp.float32)[:, None] * inv[None, :]
    cos = jnp.cos(ang)[None, :, None, :]
    sin = jnp.sin(ang)[None, :, None, :]
    xr = x[..., :ROPE_DIM].astype(jnp.float32)
    x1, x2 = xr[..., :half], xr[..., half:]
    rot = jnp.concatenate([x1 * cos - x2 * sin, x2 * cos + x1 * sin], axis=-1).astype(x.dtype)
    return jnp.concatenate([rot, x[..., ROPE_DIM:]], axis=-1)


def banded_window_attention(q, k, v, half_window):
    N, L, H, Dh = q.shape
    nb = -(-L // BLK)
    Lp = nb * BLK
    qb = jnp.pad(q, ((0, 0), (0, Lp - L), (0, 0), (0, 0))).reshape(N, nb, BLK, H, Dh)

    def neighbourhood(t):
        t = jnp.pad(t, ((0, 0), (BLK, Lp - L + BLK), (0, 0), (0, 0))).reshape(N, nb + 2, BLK, H, Dh)
        return jnp.concatenate([t[:, :-2], t[:, 1:-1], t[:, 2:]], axis=2)

    kb, vb = neighbourhood(k), neighbourhood(v)
    qpos = jnp.arange(nb)[:, None] * BLK + jnp.arange(BLK)[None, :]
    kpos = jnp.arange(nb)[:, None] * BLK - BLK + jnp.arange(3 * BLK)[None, :]
    kp = kpos[:, None, :]
    mask = (jnp.abs(qpos[:, :, None] - kp) <= half_window) & (kp >= 0) & (kp < L)
    s = jnp.einsum('nbqhd,nbkhd->nbhqk', qb, kb, preferred_element_type=jnp.float32) * (Dh ** -0.5)
    s = jnp.where(mask[None, :, None], s, NEG_INF)
    m = jnp.max(s, axis=-1, keepdims=True)
    p = jnp.exp(s - m)
    l = jnp.sum(p, axis=-1, keepdims=True)
    o = jnp.einsum('nbhqk,nbkhd->nbqhd', p.astype(v.dtype), vb, preferred_element_type=jnp.float32)
    o = o / jnp.transpose(l, (0, 1, 3, 2, 4))
    lse = jnp.transpose((m + jnp.log(l))[..., 0], (0, 1, 3, 2))
    o = o.reshape(N, Lp, H, Dh)[:, :L]
    lse = lse.reshape(N, Lp, H)[:, :L]
    return o, lse


def dilated_attention(q, k, v, dilation, half_window):
    B, S, H, Dh = q.shape
    L = S // dilation

    def split(t):
        return t.reshape(B, L, dilation, H, Dh).transpose(0, 2, 1, 3, 4).reshape(B * dilation, L, H, Dh)

    o, lse = banded_window_attention(split(q), split(k), split(v), half_window)
    o = o.reshape(B, dilation, L, H, Dh).transpose(0, 2, 1, 3, 4).reshape(B, S, H, Dh)
    lse = lse.reshape(B, dilation, L, H).transpose(0, 2, 1, 3).reshape(B, S, H)
    return o, lse


def dilated_mixture_mixer(h, w_qkv, w_o, pos):
    B, S, _ = h.shape
    qkv = (h @ w_qkv).reshape(B, S, N_GROUPS, 3, N_HEADS, HEAD_DIM)
    outs, lses = [], []
    for g, (window, dil) in enumerate(DILATED_GROUPS):
        q = rope_partial(qkv[:, :, g, 0], pos)
        k = rope_partial(qkv[:, :, g, 1], pos)
        o, lse = dilated_attention(q, k, qkv[:, :, g, 2], dil, window // (2 * dil))
        outs.append(o)
        lses.append(lse)
    wts = jax.nn.softmax(jnp.stack(lses, axis=0), axis=0)
    o = jnp.einsum('gbsh,gbshd->bshd', wts, jnp.stack(outs, axis=0))
    return o.reshape(B, S, D_MODEL).astype(h.dtype) @ w_o


def short_conv_mixer(h, w_in, conv_w, w_out):
    b_gate, c_gate, u = jnp.split(h @ w_in, 3, axis=-1)
    z = lax.conv_general_dilated(
        c_gate * u, conv_w[:, None, :], window_strides=(1,),
        padding=[((CONV_WIDTH - 1) // 2, (CONV_WIDTH - 1) // 2)],
        dimension_numbers=('NWC', 'WIO', 'NWC'), feature_group_count=D_MODEL)
    return (b_gate * z) @ w_out


def swiglu_ffn(h, w_in, w_out):
    g, u = jnp.split(h @ w_in, 2, axis=-1)
    return (jax.nn.silu(g) * u) @ w_out


def setup_inputs(seed: int = 0) -> dict:
    key = jax.random.key(seed)
    ks = jax.random.split(key, 16)
    D, F = D_MODEL, FFN_HIDDEN
    n_a = (DEPTH + N_MIXERS - 1) // N_MIXERS
    n_b = DEPTH // N_MIXERS
    nrm = lambda k, shape, fan: jax.random.normal(k, shape, jnp.float32) * (fan ** -0.5)
    return {
        "x": jax.random.normal(ks[0], (BATCH, SEQ, D), jnp.float32),
        "c": jax.random.normal(ks[1], (BATCH, D), jnp.float32),
        "attn_w_qkv": nrm(ks[2], (n_a, D, N_GROUPS * 3 * D), D),
        "attn_w_o": nrm(ks[3], (n_a, D, D), D),
        "conv_w_in": nrm(ks[4], (n_b, D, 3 * D), D),
        "conv_w": nrm(ks[5], (n_b, CONV_WIDTH, D), CONV_WIDTH),
        "conv_w_out": nrm(ks[6], (n_b, D, D), D),
        "ada_w": nrm(ks[7], (DEPTH, D, 6 * D), D),
        "ada_b": 0.02 * jax.random.normal(ks[8], (DEPTH, 6 * D), jnp.float32),
        "norm_mix_g": 1.0 + 0.02 * jax.random.normal(ks[9], (DEPTH, D), jnp.float32),
        "norm_ffn_g": 1.0 + 0.02 * jax.random.normal(ks[10], (DEPTH, D), jnp.float32),
        "ffn_w_in": nrm(ks[11], (DEPTH, D, 2 * F), D),
        "ffn_w_out": nrm(ks[12], (DEPTH, F, D), F),
        "final_g": 1.0 + 0.02 * jax.random.normal(ks[13], (D,), jnp.float32),
    }


def reference(x, c, attn_w_qkv, attn_w_o, conv_w_in, conv_w, conv_w_out, ada_w, ada_b,
              norm_mix_g, norm_ffn_g, ffn_w_in, ffn_w_out, final_g):
    pos = jnp.arange(x.shape[1], dtype=jnp.int32)
    cond = jax.nn.silu(c)
    for i in range(DEPTH):
        mod = (cond @ ada_w[i] + ada_b[i])[:, None, :]
        sh1, sc1, g1, sh2, sc2, g2 = jnp.split(mod, 6, axis=-1)
        h = modulate(rms_norm(x, norm_mix_g[i]), sh1, sc1)
        j = i // N_MIXERS
        if i % N_MIXERS == 0:
            y = dilated_mixture_mixer(h, attn_w_qkv[j], attn_w_o[j], pos)
        else:
            y = short_conv_mixer(h, conv_w_in[j], conv_w[j], conv_w_out[j])
        x = x + g1 * y
        h = modulate(rms_norm(x, norm_ffn_g[i]), sh2, sc2)
        x = x + g2 * swiglu_ffn(h, ffn_w_in[i], ffn_w_out[i])
    return rms_norm(x, final_g)
```

```cpp
#include <hip/hip_runtime.h>
#include <hip/hip_cooperative_groups.h>
#include <cstdio>
#include <cstdint>
namespace cg = cooperative_groups;

#define LAS __attribute__((address_space(3)))
#define GAS __attribute__((address_space(1)))
typedef unsigned short bf16_t;
typedef short bf16x8 __attribute__((ext_vector_type(8)));
typedef short s16x4 __attribute__((ext_vector_type(4)));
typedef float f32x4 __attribute__((ext_vector_type(4)));
typedef float f32x16 __attribute__((ext_vector_type(16)));
typedef unsigned u32x4 __attribute__((ext_vector_type(4)));
typedef unsigned u32x2 __attribute__((ext_vector_type(2)));

__device__ __forceinline__ unsigned pk2(float lo, float hi) {
    typedef __bf16 b2 __attribute__((ext_vector_type(2)));
    b2 v; v.x = (__bf16)lo; v.y = (__bf16)hi; return __builtin_bit_cast(unsigned, v);
}
template <class T> __device__ __forceinline__ GAS T* opq(T* p) { asm volatile("" : "+s"(p)); return (GAS T*)p; }
__device__ __forceinline__ float bf_lo(unsigned u) { return __uint_as_float(u << 16); }
__device__ __forceinline__ float bf_hi(unsigned u) { return __uint_as_float(u & 0xffff0000u); }

constexpr int DM = 1024, NB = 16, SEQ = 2048, MTOK = NB * SEQ, FF = 2816, NQKV = 9216, MODW = 6 * DM;
constexpr float EPS = 1e-6f;

namespace pg8 {
constexpr int BM = 256, BK = 64, HALF = 128, HTB = HALF * BK * 2, STAGE_BYTES = 8 * HTB, NXCD = 8, WGM = 8;
__host__ __device__ __forceinline__ int lds_byte(int r, int c) { const int st = (r >> 4) * 2 + (c >> 5), rr = r & 15, cc = c & 31, ob = rr * 64 + cc * 2; return st * 1024 + (ob ^ (((ob >> 9) & 1) << 5)); }
__host__ __device__ __forceinline__ void stage_rc(int b, int& R, int& C) { const int st = b / 1024, sb = b % 1024, swz = sb ^ (((sb >> 9) & 1) << 5); R = (st >> 1) * 16 + swz / 64; C = (st & 1) * 32 + (swz % 64) / 2; }
__host__ __device__ __forceinline__ int perm32(int rho) { const int n = rho >> 4, i = rho & 15; return 8 * (i >> 2) + 4 * n + (i & 3); }

struct Unit { int pm, pn; };
struct Gemm { const bf16_t* A; const bf16_t* Bt; int M, N, K; int ilv, ch; };

struct StaticOrder {
    int nM, nN, nwg, G, c;
    __device__ void init(int M, int N, int G_, int c_) { nM = M / BM; nN = N / BM; nwg = nM * nN; G = G_; c = c_; }
    __device__ bool next(int i, Unit& u) const {
        const long L = (long)i * G + c; if (L >= nwg) return false;
        int wgid = (int)L; { const int q = nwg / NXCD, r = nwg % NXCD, xcd = wgid % NXCD, off = wgid / NXCD; wgid = (xcd < r ? xcd * (q + 1) : r * (q + 1) + (xcd - r) * q) + off; }
        const int nig = WGM * nN, gid = wgid / nig, fm = gid * WGM, gsz = (nM - fm) < WGM ? (nM - fm) : WGM;
        u.pm = fm + ((wgid % nig) % gsz); u.pn = (wgid % nig) / gsz; return true;
    }
    __device__ __forceinline__ void a_ready(const Unit&) const {}
    __device__ __forceinline__ void done(const Unit&) const {}
};

struct EpiBf16 {
    static constexpr bool PERM = true;
    GAS bf16_t* O; int ldc; GAS const float* ssq; GAS const float* bias; int nb;
    __device__ __forceinline__ void operator()(const f32x4 (&acc)[2][2][4][2], const Unit& u, int wr, int wc, int fr, int fq) const {
        const int row0 = u.pm * BM + wr * 64 + fr, col0 = u.pn * BM + wc * 32 + 8 * fq;
        f32x4 bv[2][2];
#pragma unroll
        for (int bj = 0; bj < 2; ++bj)
#pragma unroll
            for (int n = 0; n < 2; ++n) bv[bj][n] = ssq ? *(GAS const f32x4*)(bias + (size_t)((u.pm * BM) >> 11) * nb + col0 + bj * HALF + 4 * n) : (f32x4){0.f, 0.f, 0.f, 0.f};
#pragma unroll
        for (int ai = 0; ai < 2; ++ai)
#pragma unroll
            for (int m = 0; m < 4; ++m) { GAS bf16_t* rowp = O + (size_t)(row0 + ai * HALF + m * 16) * ldc + col0;
                const float rs = ssq ? rsqrtf(ssq[row0 + ai * HALF + m * 16] * (1.f / DM) + EPS) : 1.f;
#pragma unroll
                for (int bj = 0; bj < 2; ++bj) { const f32x4 v0 = acc[ai][bj][m][0] * rs + bv[bj][0], v1 = acc[ai][bj][m][1] * rs + bv[bj][1];
                    u32x4 w; w.x = pk2(v0[0], v0[1]); w.y = pk2(v0[2], v0[3]); w.z = pk2(v1[0], v1[1]); w.w = pk2(v1[2], v1[3]);
                    *(GAS u32x4*)(rowp + bj * HALF) = w; } }
    }
};
__device__ __forceinline__ float silu_mul(float g, float u) { return g * __builtin_amdgcn_rcpf(1.0f + __expf(-g)) * u; }
struct EpiSwiGLU {
    static constexpr bool PERM = true;
    GAS bf16_t* O; int ldc; GAS const float* ssq; GAS const float* bias;
    __device__ __forceinline__ void operator()(const f32x4 (&acc)[2][2][4][2], const Unit& u, int wr, int wc, int fr, int fq) const {
        const int row0 = u.pm * BM + wr * 64 + fr, col0 = u.pn * HALF + wc * 32 + 8 * fq;
        GAS const float* bp = bias + (size_t)((u.pm * BM) >> 11) * (2 * FF) + col0;
        const f32x4 bg0 = *(GAS const f32x4*)(bp), bg1 = *(GAS const f32x4*)(bp + 4), bu0 = *(GAS const f32x4*)(bp + FF), bu1 = *(GAS const f32x4*)(bp + FF + 4);
        const f32x4 nbg0 = bg0 * -1.44269504088896f, nbg1 = bg1 * -1.44269504088896f;
#pragma unroll
        for (int ai = 0; ai < 2; ++ai)
#pragma unroll
            for (int m = 0; m < 4; ++m) { GAS bf16_t* rowp = O + (size_t)(row0 + ai * HALF + m * 16) * ldc + col0;
                const float rs = rsqrtf(ssq[row0 + ai * HALF + m * 16] * (1.f / DM) + EPS);
                const float nrs = rs * -1.44269504088896f;
                const f32x4 g0 = acc[ai][0][m][0] * rs + bg0, g1 = acc[ai][0][m][1] * rs + bg1, u0 = acc[ai][1][m][0] * rs + bu0, u1 = acc[ai][1][m][1] * rs + bu1;
                const f32x4 t0 = acc[ai][0][m][0] * nrs + nbg0, t1 = acc[ai][0][m][1] * nrs + nbg1;
                f32x4 e0, e1;
#pragma unroll
                for (int i = 0; i < 4; ++i) e0[i] = __builtin_amdgcn_exp2f(t0[i]);
#pragma unroll
                for (int i = 0; i < 4; ++i) e1[i] = __builtin_amdgcn_exp2f(t1[i]);
                const f32x4 d0 = e0 + 1.0f, d1 = e1 + 1.0f, gu0 = g0 * u0, gu1 = g1 * u1;
                f32x4 r0, r1;
#pragma unroll
                for (int i = 0; i < 4; ++i) r0[i] = __builtin_amdgcn_rcpf(d0[i]);
#pragma unroll
                for (int i = 0; i < 4; ++i) r1[i] = __builtin_amdgcn_rcpf(d1[i]);
                const f32x4 o0 = gu0 * r0, o1 = gu1 * r1;
                u32x4 w; w.x = pk2(o0[0], o0[1]); w.y = pk2(o0[2], o0[3]); w.z = pk2(o1[0], o1[1]); w.w = pk2(o1[2], o1[3]);
                *(GAS u32x4*)rowp = w; }
    }
};
struct EpiConvIn {
    static constexpr bool PERM = true;
    GAS bf16_t* Ob; GAS bf16_t* Ocu; GAS const float* ssq; GAS const float* bias;
    __device__ __forceinline__ void operator()(const f32x4 (&acc)[2][2][4][2], const Unit& u, int wr, int wc, int fr, int fq) const {
        const int row0 = u.pm * BM + wr * 64 + fr, bidx = (u.pm * BM) >> 11;
        if (u.pn < 4) {
            const int col0 = u.pn * BM + wc * 32 + 8 * fq;
            f32x4 bv[2][2];
#pragma unroll
            for (int bj = 0; bj < 2; ++bj)
#pragma unroll
                for (int n = 0; n < 2; ++n) bv[bj][n] = *(GAS const f32x4*)(bias + (size_t)bidx * (3 * DM) + col0 + bj * HALF + 4 * n);
#pragma unroll
            for (int ai = 0; ai < 2; ++ai)
#pragma unroll
                for (int m = 0; m < 4; ++m) { GAS bf16_t* rowp = Ob + (size_t)(row0 + ai * HALF + m * 16) * DM + col0;
                    const float rs = rsqrtf(ssq[row0 + ai * HALF + m * 16] * (1.f / DM) + EPS);
#pragma unroll
                    for (int bj = 0; bj < 2; ++bj) { const f32x4 v0 = acc[ai][bj][m][0] * rs + bv[bj][0], v1 = acc[ai][bj][m][1] * rs + bv[bj][1];
                        u32x4 w; w.x = pk2(v0[0], v0[1]); w.y = pk2(v0[2], v0[3]); w.z = pk2(v1[0], v1[1]); w.w = pk2(v1[2], v1[3]);
                        *(GAS u32x4*)(rowp + bj * HALF) = w; } }
        } else {
            const int col0 = (u.pn - 4) * HALF + wc * 32 + 8 * fq;
            GAS const float* bp = bias + (size_t)bidx * (3 * DM) + DM + col0;
            const f32x4 bc0 = *(GAS const f32x4*)(bp), bc1 = *(GAS const f32x4*)(bp + 4), bu0 = *(GAS const f32x4*)(bp + DM), bu1 = *(GAS const f32x4*)(bp + DM + 4);
#pragma unroll
            for (int ai = 0; ai < 2; ++ai)
#pragma unroll
                for (int m = 0; m < 4; ++m) { GAS bf16_t* rowp = Ocu + (size_t)(row0 + ai * HALF + m * 16) * DM + col0;
                    const float rs = rsqrtf(ssq[row0 + ai * HALF + m * 16] * (1.f / DM) + EPS);
                    const f32x4 p0 = (acc[ai][0][m][0] * rs + bc0) * (acc[ai][1][m][0] * rs + bu0), p1 = (acc[ai][0][m][1] * rs + bc1) * (acc[ai][1][m][1] * rs + bu1);
                    u32x4 w; w.x = pk2(p0[0], p0[1]); w.y = pk2(p0[2], p0[3]); w.z = pk2(p1[0], p1[1]); w.w = pk2(p1[2], p1[3]);
                    *(GAS u32x4*)rowp = w; }
        }
    }
};
__device__ __forceinline__ f32x4 cf_make(GAS const float* gain, GAS const float* scale, int col) {
    f32x4 c = *(GAS const f32x4*)(gain + col); if (scale) c = c * (*(GAS const f32x4*)(scale + col) + 1.0f);
#pragma unroll
    for (int i = 0; i < 4; ++i) if (fabsf(c[i]) < 1e-6f) c[i] = c[i] < 0.f ? -1e-6f : 1e-6f;
    return c;
}
struct EpiResid {
    static constexpr bool PERM = true;
    GAS const float* resid32; GAS const float* pgain; GAS const float* pscale; GAS const float* gate; GAS const float* ngain; GAS const float* nscale; GAS bf16_t* Hn; GAS float* ssq; int pbase, ilv, ch;
    __device__ __forceinline__ void operator()(const f32x4 (&acc)[2][2][4][2], const Unit& u, int wr, int wc, int fr, int fq) const {
        const int prow0 = (ilv ? (((u.pm >> 3) * 2 + ch) * 8 + (u.pm & 7)) : (pbase + u.pm)) * BM;
        const int b = prow0 >> 11;
        const int col0 = u.pn * BM + wc * 32 + 8 * fq;
        GAS const float* gp = gate + (size_t)b * MODW + col0;
        f32x4 gv[2][2], cf[2][2], rcf[2][2];
#pragma unroll
        for (int bj = 0; bj < 2; ++bj)
#pragma unroll
            for (int n = 0; n < 2; ++n) { gv[bj][n] = *(GAS const f32x4*)(gp + bj * HALF + n * 4);
                cf[bj][n] = cf_make(ngain, nscale ? nscale + (size_t)b * MODW : nullptr, col0 + bj * HALF + n * 4);
                if (!resid32) { const f32x4 pc = cf_make(pgain, pscale + (size_t)b * MODW, col0 + bj * HALF + n * 4); rcf[bj][n] = (f32x4){__builtin_amdgcn_rcpf(pc.x), __builtin_amdgcn_rcpf(pc.y), __builtin_amdgcn_rcpf(pc.z), __builtin_amdgcn_rcpf(pc.w)}; }
                else rcf[bj][n] = (f32x4){0.f, 0.f, 0.f, 0.f}; }
#pragma unroll
        for (int ai = 0; ai < 2; ++ai)
#pragma unroll
            for (int m = 0; m < 4; ++m) { const int row = prow0 + ai * HALF + wr * 64 + m * 16 + fr; const size_t off = (size_t)row * DM + col0; float s = 0.f;
#pragma unroll
                for (int bj = 0; bj < 2; ++bj) {
                    f32x4 r0, r1;
                    if (resid32) { r0 = *(GAS const f32x4*)(resid32 + off + bj * HALF); r1 = *(GAS const f32x4*)(resid32 + off + bj * HALF + 4); }
                    else { const u32x4 rr = *(GAS const u32x4*)(Hn + off + bj * HALF);
                        r0 = (f32x4){bf_lo(rr.x), bf_hi(rr.x), bf_lo(rr.y), bf_hi(rr.y)} * rcf[bj][0]; r1 = (f32x4){bf_lo(rr.z), bf_hi(rr.z), bf_lo(rr.w), bf_hi(rr.w)} * rcf[bj][1]; }
                    const f32x4 x0 = r0 + gv[bj][0] * acc[ai][bj][m][0], x1 = r1 + gv[bj][1] * acc[ai][bj][m][1];
                    s += (x0.x * x0.x + x0.y * x0.y) + (x0.z * x0.z + x0.w * x0.w) + (x1.x * x1.x + x1.y * x1.y) + (x1.z * x1.z + x1.w * x1.w);
                    const f32x4 h0 = x0 * cf[bj][0], h1 = x1 * cf[bj][1];
                    u32x4 w; w.x = pk2(h0.x, h0.y); w.y = pk2(h0.z, h0.w); w.z = pk2(h1.x, h1.y); w.w = pk2(h1.z, h1.w);
                    *(GAS u32x4*)(Hn + off + bj * HALF) = w;
                }
                s += __shfl_xor(s, 16); s += __shfl_xor(s, 32);
                if (fq == 0) __hip_atomic_fetch_add(ssq + row, s, __ATOMIC_RELAXED, __HIP_MEMORY_SCOPE_AGENT);
                if (m & 1) asm volatile("" ::: "memory"); }
    }
};

template <class Epi, class Sched, bool ALIGN_EPI = true, bool SP2 = true>
__device__ __forceinline__ void gemm_phase(LAS unsigned char* lds, const Gemm g, const Sched& S, const Epi& E) {
    int tid = threadIdx.x; asm volatile("" : "+v"(tid));
    const int wid = __builtin_amdgcn_readfirstlane(tid >> 6), lane = tid & 63, wr = wid >> 2, wc = wid & 3, fr = lane & 15, fq = lane >> 4;
    const int K = g.K, nt = K / BK;
    const char* gA = (const char*)g.A; const char* gB = (const char*)g.Bt; asm volatile("" : "+s"(gA), "+s"(gB));
    unsigned voffA[2], voffB[2];
#pragma unroll
    for (int i = 0; i < 2; ++i) { int R, C; stage_rc(tid * 16 + i * 8192, R, C); const int Rb = Epi::PERM ? ((R & ~31) + perm32(R & 31)) : R;
        voffA[i] = (unsigned)(R * K + C) * 2u; voffB[i] = (unsigned)(Rb * K + C) * 2u; }
    const size_t kstep = (size_t)(BK * 2);
    const size_t hstep = (size_t)HALF * K * 2;
    const size_t tstep = 2 * hstep;
    const unsigned ldsw = (unsigned)wid * 1024u;
    const int aoff = lds_byte(wr * 64 + fr, fq * 8), boff = lds_byte(wc * 32 + fr, fq * 8);
#define PG8_SA(b, h) (((b) * 2 + (h)) * HTB)
#define PG8_SB(b, h) ((4 + (b) * 2 + (h)) * HTB)
#define PG8_STAGE(bufoff, gbase, voff) do { _Pragma("unroll") for (int _i = 0; _i < 2; ++_i) \
        __builtin_amdgcn_global_load_lds((const unsigned*)((const char*)(gbase) + (voff)[_i]), (LAS unsigned*)(lds + (bufoff) + ldsw + _i * 8192), 16, 0, 0); } while (0)
#define PG8_LDA(dst, b, h) do { _Pragma("unroll") for (int m = 0; m < 4; ++m) _Pragma("unroll") for (int k = 0; k < 2; ++k) dst[m][k] = *(const LAS bf16x8*)(lds + PG8_SA(b, h) + aoff + m * 2048 + k * 1024); } while (0)
#define PG8_LDB(dst, b, h) do { _Pragma("unroll") for (int n = 0; n < 2; ++n) _Pragma("unroll") for (int k = 0; k < 2; ++k) dst[n][k] = *(const LAS bf16x8*)(lds + PG8_SB(b, h) + boff + n * 2048 + k * 1024); } while (0)
#define PG8_MMA(ai, bj, At, Bt) do { __builtin_amdgcn_s_setprio(1); _Pragma("unroll") for (int m = 0; m < 4; ++m) _Pragma("unroll") for (int n = 0; n < 2; ++n) _Pragma("unroll") for (int k = 0; k < 2; ++k) \
        acc[ai][bj][m][n] = __builtin_amdgcn_mfma_f32_16x16x32_bf16(Bt[n][k], At[m][k], acc[ai][bj][m][n], 0, 0, 0); __builtin_amdgcn_s_setprio(0); } while (0)
#define PG8_WAIT_V(n) asm volatile("s_waitcnt vmcnt(" #n ")" ::: "memory")
#define PG8_WAIT_L(n) asm volatile("s_waitcnt lgkmcnt(" #n ")" ::: "memory")
#define PG8_BAR __builtin_amdgcn_s_barrier()
#define PG8_SCHED __builtin_amdgcn_sched_barrier(0)
    Unit cur, nxt; int ui = 0;
    if (!S.next(0, cur)) return;
    f32x4 acc[2][2][4][2];
#pragma unroll
    for (int a = 0; a < 2; ++a)
#pragma unroll
        for (int b = 0; b < 2; ++b)
#pragma unroll
            for (int m = 0; m < 4; ++m)
#pragma unroll
                for (int n = 0; n < 2; ++n) acc[a][b][m][n] = (f32x4){0.f, 0.f, 0.f, 0.f};
    bf16x8 At[4][2], B0[2][2], B1[2][2];
#define PG8_AMAP(pm) (g.ilv ? ((((pm) >> 3) * 2 + g.ch) * 8 + ((pm) & 7)) : (pm))
    const char* cA = gA + (size_t)PG8_AMAP(cur.pm) * tstep; const char* cB = gB + (size_t)cur.pn * tstep;
    S.a_ready(cur);
    if constexpr (SP2) {
        PG8_STAGE(PG8_SB(0, 0), cB, voffB); PG8_STAGE(PG8_SB(0, 1), cB + hstep, voffB); PG8_STAGE(PG8_SA(0, 0), cA, voffA); PG8_STAGE(PG8_SA(0, 1), cA + hstep, voffA);
        if (wr == 1) PG8_BAR;
        PG8_WAIT_V(2); PG8_BAR;
        PG8_STAGE(PG8_SB(1, 0), cB + kstep, voffB); PG8_STAGE(PG8_SA(1, 0), cA + kstep, voffA); PG8_STAGE(PG8_SB(1, 1), cB + hstep + kstep, voffB);
        PG8_WAIT_V(6); PG8_BAR;
    } else {
        PG8_STAGE(PG8_SB(0, 0), cB, voffB); PG8_STAGE(PG8_SA(0, 0), cA, voffA); PG8_STAGE(PG8_SB(0, 1), cB + hstep, voffB); PG8_STAGE(PG8_SA(0, 1), cA + hstep, voffA);
        if (wr == 1) PG8_BAR;
        PG8_WAIT_V(4); PG8_BAR;
        PG8_STAGE(PG8_SB(1, 0), cB + kstep, voffB); PG8_STAGE(PG8_SA(1, 0), cA + kstep, voffA); PG8_STAGE(PG8_SB(1, 1), cB + hstep + kstep, voffB);
        PG8_WAIT_V(6); PG8_BAR;
    }
    for (;;) {
        const bool has_next = S.next(ui + 1, nxt);
        const char* nA = has_next ? gA + (size_t)PG8_AMAP(nxt.pm) * tstep : cA; const char* nB = has_next ? gB + (size_t)nxt.pn * tstep : cB;
        for (int t = 0; t < nt; t += 2) {
            const bool last = (t == nt - 2);
            const char* a1 = cA + (size_t)(t + 1) * kstep;
            const char* a2 = last ? nA : cA + (size_t)(t + 2) * kstep; const char* b2 = last ? nB : cB + (size_t)(t + 2) * kstep;
            const char* a3 = a2 + kstep; const char* b3 = b2 + kstep;
            if (last && has_next) S.a_ready(nxt);
            if constexpr (SP2) {
            PG8_LDB(B0, 0, 0); PG8_LDB(B1, 0, 1); PG8_SCHED; PG8_LDA(At, 0, 0); PG8_STAGE(PG8_SA(1, 1), a1 + hstep, voffA);
            PG8_WAIT_V(8); PG8_WAIT_L(0); PG8_BAR; PG8_MMA(0, 0, At, B0); PG8_MMA(0, 1, At, B1); PG8_BAR; PG8_SCHED;
            PG8_LDA(At, 0, 1); PG8_STAGE(PG8_SB(0, 0), b2, voffB); PG8_STAGE(PG8_SB(0, 1), b2 + hstep, voffB); PG8_STAGE(PG8_SA(0, 0), a2, voffA);
            PG8_WAIT_V(8); PG8_WAIT_L(0); PG8_BAR; PG8_MMA(1, 0, At, B0); PG8_MMA(1, 1, At, B1); PG8_BAR; PG8_SCHED;
            PG8_LDB(B0, 1, 0); PG8_LDB(B1, 1, 1); PG8_SCHED; PG8_LDA(At, 1, 0); PG8_STAGE(PG8_SA(0, 1), a2 + hstep, voffA);
            PG8_WAIT_V(8); PG8_WAIT_L(0); PG8_BAR; PG8_MMA(0, 0, At, B0); PG8_MMA(0, 1, At, B1); PG8_BAR; PG8_SCHED;
            PG8_LDA(At, 1, 1); PG8_STAGE(PG8_SB(1, 0), b3, voffB); PG8_STAGE(PG8_SB(1, 1), b3 + hstep, voffB); PG8_STAGE(PG8_SA(1, 0), a3, voffA);
            PG8_WAIT_V(8); PG8_WAIT_L(0); PG8_BAR; PG8_MMA(1, 0, At, B0); PG8_MMA(1, 1, At, B1); PG8_BAR; PG8_SCHED;
            } else {
            PG8_LDB(B0, 0, 0); PG8_SCHED; PG8_LDA(At, 0, 0); PG8_STAGE(PG8_SA(1, 1), a1 + hstep, voffA);
            PG8_WAIT_L(8); PG8_BAR; PG8_WAIT_L(0); PG8_MMA(0, 0, At, B0); PG8_BAR; PG8_SCHED;
            PG8_LDB(B1, 0, 1); PG8_STAGE(PG8_SB(0, 0), b2, voffB);
            PG8_BAR; PG8_WAIT_L(0); PG8_MMA(0, 1, At, B1); PG8_BAR;
            PG8_LDA(At, 0, 1); PG8_STAGE(PG8_SA(0, 0), a2, voffA);
            PG8_BAR; PG8_WAIT_L(0); PG8_MMA(1, 0, At, B0); PG8_BAR; PG8_SCHED;
            PG8_STAGE(PG8_SB(0, 1), b2 + hstep, voffB);
            PG8_WAIT_V(6); PG8_BAR; PG8_MMA(1, 1, At, B1); PG8_BAR;
            PG8_LDB(B0, 1, 0); PG8_SCHED; PG8_LDA(At, 1, 0); PG8_STAGE(PG8_SA(0, 1), a2 + hstep, voffA);
            PG8_WAIT_L(8); PG8_BAR; PG8_WAIT_L(0); PG8_MMA(0, 0, At, B0); PG8_BAR; PG8_SCHED;
            PG8_LDB(B1, 1, 1); PG8_STAGE(PG8_SB(1, 0), b3, voffB);
            PG8_BAR; PG8_WAIT_L(0); PG8_MMA(0, 1, At, B1); PG8_BAR;
            PG8_LDA(At, 1, 1); PG8_STAGE(PG8_SA(1, 0), a3, voffA);
            PG8_BAR; PG8_WAIT_L(0); PG8_MMA(1, 0, At, B0); PG8_BAR; PG8_SCHED;
            PG8_STAGE(PG8_SB(1, 1), b3 + hstep, voffB);
            PG8_WAIT_V(6); PG8_BAR; PG8_MMA(1, 1, At, B1); PG8_BAR;
            }
        }
        if constexpr (ALIGN_EPI) { if (wr == 0) PG8_BAR; }
        E(acc, cur, wr, wc, fr, fq); S.done(cur);
        if (!has_next) break;
#pragma unroll
        for (int a = 0; a < 2; ++a)
#pragma unroll
            for (int b = 0; b < 2; ++b)
#pragma unroll
                for (int m = 0; m < 4; ++m)
#pragma unroll
                    for (int n = 0; n < 2; ++n) acc[a][b][m][n] = (f32x4){0.f, 0.f, 0.f, 0.f};
        cur = nxt; cA = nA; cB = nB; ++ui;
        if constexpr (ALIGN_EPI) { if (wr == 1) PG8_BAR; }
    }
    PG8_WAIT_V(0);
    if constexpr (!ALIGN_EPI) { if (wr == 0) PG8_BAR; }
    PG8_BAR;
#undef PG8_AMAP
#undef PG8_SA
#undef PG8_SB
#undef PG8_STAGE
#undef PG8_LDA
#undef PG8_LDB
#undef PG8_MMA
#undef PG8_WAIT_V
#undef PG8_WAIT_L
#undef PG8_BAR
#undef PG8_SCHED
}
}

constexpr size_t MiB = 1u << 20;
constexpr size_t WS_MOD = 0;
constexpr size_t WS_ROPE = 1 * MiB;
constexpr size_t WS_WQKV = 2 * MiB;
constexpr size_t WS_WO = 20 * MiB;
constexpr size_t WS_CIN = 22 * MiB;
constexpr size_t WS_COUT = 28 * MiB;
constexpr size_t WS_FIN = 30 * MiB;
constexpr size_t WS_FOUT = 52 * MiB;
constexpr size_t WS_H = 64 * MiB;
constexpr size_t WS_O = 128 * MiB;
constexpr size_t WS_LSE = 192 * MiB;
constexpr size_t WS_SSQ = 1 * MiB + 512 * 1024;
constexpr size_t WS_BIASV = 198 * MiB;
constexpr size_t WS_BIG = 200 * MiB;
constexpr size_t BCU_OFF = 176 * MiB;
constexpr size_t FIN_BYTES = (size_t)2 * FF * DM * 2, FOUT_BYTES = (size_t)DM * FF * 2;

constexpr size_t WS_BAR = 1 * MiB + 256 * 1024;
constexpr int LDS_BYTES = 147456;

struct Args { const float* in[14]; float* out; unsigned char* ws; int nchunk; int flags; };

__device__ __forceinline__ float wave_sum(float v) {
#pragma unroll
    for (int o = 1; o < 64; o <<= 1) v += __shfl_xor(v, o);
    return v;
}

__device__ __forceinline__ void p0_transpose_item(const float* W, int K, int N, bf16_t* WT, int k0, int n0, int drow0, LAS float* scr, int lane) {
    float wv[32];
    GAS const float* wsrc = (GAS const float*)W + (size_t)(k0 + (lane >> 5)) * N + n0 + (lane & 31);
#pragma unroll
    for (int i = 0; i < 32; ++i) wv[i] = wsrc[(size_t)(2 * i) * N];
#pragma unroll
    for (int i = 0; i < 32; ++i) scr[(2 * i + (lane >> 5)) * 33 + (lane & 31)] = wv[i];
    asm volatile("s_waitcnt lgkmcnt(0)" ::: "memory");
    const int c = lane & 7;
#pragma unroll
    for (int j = 0; j < 4; ++j) { const int n = (lane >> 3) + 8 * j; const LAS float* s = scr + (8 * c) * 33 + n;
        u32x4 o; o.x = pk2(s[0 * 33], s[1 * 33]); o.y = pk2(s[2 * 33], s[3 * 33]); o.z = pk2(s[4 * 33], s[5 * 33]); o.w = pk2(s[6 * 33], s[7 * 33]);
        *(GAS u32x4*)((GAS bf16_t*)WT + (size_t)(drow0 + n) * K + k0 + 8 * c) = o; }
    asm volatile("s_waitcnt lgkmcnt(0)" ::: "memory");
}

__device__ __forceinline__ void norm_rows(const float* x_, const float* gvec_, const float* modl_, int sh_off, int sc_off, bf16_t* H_, int row_lo, int row_hi, int gw, int NGW, int lane) {
    GAS const float* x = opq(x_); GAS const float* gvec = opq(gvec_); GAS const float* modl = opq(modl_); GAS bf16_t* H = opq(H_); asm volatile("" : "+v"(lane));
    for (int row = row_lo + gw; row < row_hi; row += NGW) {
        const int b = row >> 11;
        GAS const f32x4* xr = (GAS const f32x4*)(x + (size_t)row * DM) + lane;
        f32x4 v[4]; float s = 0.f;
#pragma unroll
        for (int j = 0; j < 4; ++j) { v[j] = xr[64 * j]; s += (v[j].x * v[j].x + v[j].y * v[j].y) + (v[j].z * v[j].z + v[j].w * v[j].w); }
        const float rstd = rsqrtf(wave_sum(s) * (1.f / DM) + EPS);
        GAS u32x2* o8 = (GAS u32x2*)(H + (size_t)row * DM) + lane;
        GAS const float* mb = modl + (size_t)b * MODW;
#pragma unroll
        for (int j = 0; j < 4; ++j) { const int col = 4 * lane + 256 * j;
            const f32x4 g4 = *(GAS const f32x4*)(gvec + col), sc4 = *(GAS const f32x4*)(mb + sc_off + col), sh4 = *(GAS const f32x4*)(mb + sh_off + col);
            const f32x4 o = (v[j] * rstd) * g4 * (sc4 + 1.0f) + sh4;
            u32x2 w; w.x = pk2(o.x, o.y); w.y = pk2(o.z, o.w); o8[64 * j] = w; }
    }
}

__device__ __forceinline__ void gemv16_item(GAS const float* vec, int vstride, bool do_silu, GAS const float* W, int N, int cb, GAS const float* bias, GAS float* outp, LAS unsigned char* lds, int tid, int wave, int lane) {
    LAS float* cs = (LAS float*)lds + wave * 2048;
    LAS float* red = (LAS float*)(lds + 65536);
    const int n = cb * 64 + lane;
#pragma unroll
    for (int b = 0; b < 16; ++b)
#pragma unroll
        for (int j = 0; j < 2; ++j) { const int kk = lane + 64 * j; const float v = vec[(size_t)b * vstride + 128 * wave + kk]; cs[b * 128 + kk] = do_silu ? v * __builtin_amdgcn_rcpf(1.f + __expf(-v)) : v; }
    float acc[16];
#pragma unroll
    for (int b = 0; b < 16; ++b) acc[b] = 0.f;
    GAS const float* wp = W + (size_t)(128 * wave) * N + n;
#pragma unroll 2
    for (int kk = 0; kk < 128; kk += 8) {
        float w[8];
#pragma unroll
        for (int e = 0; e < 8; ++e) w[e] = wp[(size_t)(kk + e) * N];
#pragma unroll
        for (int b = 0; b < 16; ++b) { const f32x4 c0 = *(const LAS f32x4*)(cs + b * 128 + kk), c1 = *(const LAS f32x4*)(cs + b * 128 + kk + 4);
            acc[b] += ((c0.x * w[0] + c0.y * w[1]) + (c0.z * w[2] + c0.w * w[3])) + ((c1.x * w[4] + c1.y * w[5]) + (c1.z * w[6] + c1.w * w[7])); }
    }
#pragma unroll
    for (int b = 0; b < 16; ++b) red[(wave * 16 + b) * 64 + lane] = acc[b];
    __syncthreads();
    for (int o = tid; o < 1024; o += 512) { const int b = o >> 6, l = o & 63; float s = 0.f;
#pragma unroll
        for (int w = 0; w < 8; ++w) s += red[(w * 16 + b) * 64 + l];
        const int nn = cb * 64 + l; outp[(size_t)b * N + nn] = s + (bias ? bias[nn] : 0.f); }
    __syncthreads();
}

__device__ __forceinline__ int crow(int reg, int h) { return (reg & 3) + 8 * (reg >> 2) + 4 * h; }
__device__ __forceinline__ void rope_cs(int pos, float (&cs)[8], float (&sn)[8]) {
    const float C[8] = {1.591549431e-01f, 3.086376340e-02f, 5.985185713e-03f, 1.160663641e-03f, 2.250790790e-04f, 4.364795279e-05f, 8.464330808e-06f, 1.641426263e-06f};
#pragma unroll
    for (int j = 0; j < 8; ++j) { const float rev = __builtin_amdgcn_fractf((float)pos * C[j]); cs[j] = __builtin_amdgcn_cosf(rev); sn[j] = __builtin_amdgcn_sinf(rev); }
}
__device__ __forceinline__ bf16x8 rope_frag(bf16x8 f, int pos, int hh) {
    u32x4 own = __builtin_bit_cast(u32x4, f), oth;
#pragma unroll
    for (int i = 0; i < 4; ++i) oth[i] = (unsigned)__shfl_xor((int)own[i], 32);
    float cs[8], sn[8]; rope_cs(pos, cs, sn);
    const float sg = hh ? 1.f : -1.f;
    u32x4 r;
#pragma unroll
    for (int i = 0; i < 4; ++i) {
        const float lo = bf_lo(own[i]) * cs[2 * i] + sg * bf_lo(oth[i]) * sn[2 * i];
        const float hi = bf_hi(own[i]) * cs[2 * i + 1] + sg * bf_hi(oth[i]) * sn[2 * i + 1];
        r[i] = pk2(lo, hi);
    }
    return __builtin_bit_cast(bf16x8, r);
}
#define MFMA32(a, b, c) __builtin_amdgcn_mfma_f32_32x32x16_bf16((a), (b), (c), 0, 0, 0)

constexpr int AT_KT = 4608, AT_VOFF = 12 * AT_KT, AT_VT = 4096, AT_OST = AT_VOFF + 12 * AT_VT, AT_OSTW = 32 * 144;
struct AttnPre { u32x4 ka[3], kb[3]; bf16x8 qf[4]; };
struct AttnGeo { int h, g, bl, dil, L, tsh, T0, ntile, ur, up0; };
__device__ __forceinline__ AttnGeo attn_geo(int U) {
    AttnGeo a; const int t8 = U & 7, rest = U >> 7; a.h = (U >> 3) & 15; a.g = rest % 3; a.bl = rest / 3;
    const int sh = 2 * a.g; a.dil = 1 << sh; a.L = SEQ >> sh; a.tsh = 6 - sh; a.T0 = t8 * 8; a.ntile = a.g < 2 ? 12 : 8;
    a.ur = a.T0 >> a.tsh; a.up0 = 32 * (a.T0 & ((1 << a.tsh) - 1)) - 64; return a;
}
__device__ __forceinline__ void attn_prefetch(GAS const bf16_t* qkv, int U, int tid, int wave, int lane, AttnPre& R) {
    const AttnGeo a = attn_geo(U);
    GAS const bf16_t* base = qkv + (size_t)a.bl * SEQ * NQKV + a.g * 3072 + a.h * 64;
#pragma unroll
    for (int k = 0; k < 3; ++k) {
        const int i = tid + 512 * k, j = i >> 7;
        const int rj = a.g < 2 ? a.ur : (a.T0 >> 2) + (j >> 2), pj = a.g < 2 ? a.up0 + 32 * j : 32 * (j & 3);
        const bool valid = j < a.ntile && pj >= 0 && pj < a.L;
        const int row = (i & 127) >> 2, pr = i & 3, tok = valid ? (pj + row) * a.dil + rj : 0;
        GAS const bf16_t* src = base + 1024 + (size_t)tok * NQKV + pr * 16;
        R.ka[k] = *(GAS const u32x4*)src; R.kb[k] = *(GAS const u32x4*)(src + 8);
    }
    const int r32 = lane & 31, hh = lane >> 5, Tw = a.T0 + wave, rw = Tw >> a.tsh, q0 = 32 * (Tw & ((1 << a.tsh) - 1));
    GAS const bf16_t* qrow = base + (size_t)((q0 + r32) * a.dil + rw) * NQKV;
#pragma unroll
    for (int ds = 0; ds < 4; ++ds) R.qf[ds] = *(GAS const bf16x8*)(qrow + 16 * ds + 8 * hh);
}
__device__ __forceinline__ void attn_unit(GAS bf16_t* qkv, GAS float* lse, LAS unsigned char* lds, int U, int Unext, int tid, int wave, int lane, AttnPre& R) {
    asm volatile("" : "+v"(lane));
    const AttnGeo a = attn_geo(U);
    const int g = a.g, h = a.h, bl = a.bl, dil = a.dil, L = a.L, tsh = a.tsh, T0 = a.T0, ntile = a.ntile, ur = a.ur, up0 = a.up0;
    GAS bf16_t* base = qkv + (size_t)bl * SEQ * NQKV + g * 3072 + h * 64;
    const int r32 = lane & 31, hh = lane >> 5;
    const int Tw = T0 + wave, rw = Tw >> tsh, q0 = 32 * (Tw & ((1 << tsh) - 1));
    const int tq = (q0 + r32) * dil + rw;
    GAS bf16_t* qrow = base + (size_t)tq * NQKV;
#pragma unroll
    for (int k = 0; k < 3; ++k) {
        const int i = tid + 512 * k, j = i >> 7;
        const int rj = g < 2 ? ur : (T0 >> 2) + (j >> 2), pj = g < 2 ? up0 + 32 * j : 32 * (j & 3);
        if (j < ntile && pj >= 0 && pj < L) {
            const int row = (i & 127) >> 2, pr = i & 3, tok = (pj + row) * dil + rj;
            u32x4 ka = R.ka[k], kb = R.kb[k];
            if (pr == 0) {
                float cs[8], sn[8]; rope_cs(tok, cs, sn);
#pragma unroll
                for (int e = 0; e < 4; ++e) {
                    const float x1l = bf_lo(ka[e]), x1h = bf_hi(ka[e]), x2l = bf_lo(kb[e]), x2h = bf_hi(kb[e]);
                    ka[e] = pk2(x1l * cs[2 * e] - x2l * sn[2 * e], x1h * cs[2 * e + 1] - x2h * sn[2 * e + 1]);
                    kb[e] = pk2(x2l * cs[2 * e] + x1l * sn[2 * e], x2h * cs[2 * e + 1] + x1h * sn[2 * e + 1]);
                }
            }
            LAS unsigned char* dst = lds + j * AT_KT + row * 144 + pr * 32;
            *(LAS u32x4*)dst = ka; *(LAS u32x4*)(dst + 16) = kb;
        }
    }
    bf16x8 qf[4];
#pragma unroll
    for (int ds = 0; ds < 4; ++ds) qf[ds] = R.qf[ds];
    qf[0] = rope_frag(qf[0], tq, hh);
    for (int i = wave; i < ntile * 4; i += 8) {
        const int j = i >> 2, dt = (i >> 1) & 1, kh = i & 1;
        const int rj = g < 2 ? ur : (T0 >> 2) + (j >> 2), pj = g < 2 ? up0 + 32 * j : 32 * (j & 3);
        if (pj >= 0 && pj < L) {
            const int key = pj + 16 * kh + (lane >> 2);
            GAS const bf16_t* src = base + 2048 + (size_t)(key * dil + rj) * NQKV + dt * 32 + (lane & 3) * 8;
            __builtin_amdgcn_global_load_lds((const unsigned*)src, (LAS unsigned*)(lds + AT_VOFF + j * AT_VT + dt * 2048 + kh * 1024), 16, 0, 0);
        }
    }
    asm volatile("" ::: "memory"); __builtin_amdgcn_sched_barrier(0);
    attn_prefetch(qkv, Unext, tid, wave, lane, R);
    asm volatile("s_waitcnt vmcnt(10) lgkmcnt(0)" ::: "memory");
    __builtin_amdgcn_s_barrier(); asm volatile("" ::: "memory");
    f32x16 sacc[5];
    const float NEG = -INFINITY;
#pragma unroll
    for (int kt = 0; kt < 5; ++kt) {
        const int kp0 = q0 - 64 + 32 * kt;
        if (kp0 >= 0 && kp0 < L) {
            const int j = g < 2 ? wave + kt : 4 * (wave >> 2) + (kp0 >> 5);
            const LAS unsigned char* kp = lds + j * AT_KT + r32 * 144 + hh * 16;
            f32x16 av;
#pragma unroll
            for (int i = 0; i < 16; ++i) av[i] = 0.f;
#pragma unroll
            for (int ds = 0; ds < 4; ++ds) av = MFMA32(*(const LAS bf16x8*)(kp + 32 * ds), qf[ds], av);
            if (kt == 0) {
#pragma unroll
                for (int i = 0; i < 16; ++i) if (crow(i, hh) < r32) av[i] = NEG;
            }
            if (kt == 4) {
#pragma unroll
                for (int i = 0; i < 16; ++i) if (crow(i, hh) > r32) av[i] = NEG;
            }
            sacc[kt] = av;
        } else {
#pragma unroll
            for (int i = 0; i < 16; ++i) sacc[kt][i] = NEG;
        }
    }
    float m = NEG;
#pragma unroll
    for (int kt = 0; kt < 5; ++kt)
#pragma unroll
        for (int i = 0; i < 16; ++i) m = fmaxf(m, sacc[kt][i]);
    m = fmaxf(m, __shfl_xor(m, 32));
    const float C = 0.125f * 1.44269504088896f, mC = m * C;
    float lsum = 0.f;
    bf16x8 pb[5][2];
#pragma unroll
    for (int kt = 0; kt < 5; ++kt) {
        float p[16];
#pragma unroll
        for (int i = 0; i < 16; ++i) { p[i] = __builtin_amdgcn_exp2f(sacc[kt][i] * C - mC); lsum += p[i]; }
#pragma unroll
        for (int s = 0; s < 2; ++s) { u32x4 w; w.x = pk2(p[8 * s], p[8 * s + 1]); w.y = pk2(p[8 * s + 2], p[8 * s + 3]); w.z = pk2(p[8 * s + 4], p[8 * s + 5]); w.w = pk2(p[8 * s + 6], p[8 * s + 7]);
            pb[kt][s] = __builtin_bit_cast(bf16x8, w); }
    }
    lsum += __shfl_xor(lsum, 32);
    f32x16 oacc[2];
#pragma unroll
    for (int dt = 0; dt < 2; ++dt)
#pragma unroll
        for (int i = 0; i < 16; ++i) oacc[dt][i] = 0.f;
    const int i16 = lane & 15, blk = (lane >> 4) & 1;
    const unsigned vb = (unsigned)((4 * hh + (i16 >> 2)) * 64 + 32 * blk + 8 * (i16 & 3));
#pragma unroll
    for (int kt = 0; kt < 5; ++kt) {
        const int kp0 = q0 - 64 + 32 * kt;
        if (kp0 >= 0 && kp0 < L) {
            const int j = g < 2 ? wave + kt : 4 * (wave >> 2) + (kp0 >> 5);
            LAS unsigned char* slot = lds + AT_VOFF + j * AT_VT + vb;
#pragma unroll
            for (int dt = 0; dt < 2; ++dt)
#pragma unroll
                for (int s = 0; s < 2; ++s) {
                    const s16x4 lo = __builtin_amdgcn_ds_read_tr16_b64_v4i16((LAS s16x4*)(slot + dt * 2048 + s * 1024));
                    const s16x4 hi = __builtin_amdgcn_ds_read_tr16_b64_v4i16((LAS s16x4*)(slot + dt * 2048 + s * 1024 + 512));
                    const bf16x8 va = __builtin_shufflevector(lo, hi, 0, 1, 2, 3, 4, 5, 6, 7);
                    oacc[dt] = MFMA32(va, pb[kt][s], oacc[dt]);
                }
        }
    }
    const float inv = __builtin_amdgcn_rcpf(lsum);
    LAS unsigned char* ost = lds + AT_OST + wave * AT_OSTW;
#pragma unroll
    for (int dt = 0; dt < 2; ++dt)
#pragma unroll
        for (int g4 = 0; g4 < 4; ++g4) {
            u32x2 w; w.x = pk2(oacc[dt][4 * g4] * inv, oacc[dt][4 * g4 + 1] * inv); w.y = pk2(oacc[dt][4 * g4 + 2] * inv, oacc[dt][4 * g4 + 3] * inv);
            *(LAS u32x2*)(ost + r32 * 144 + (32 * dt + 8 * g4 + 4 * hh) * 2) = w;
        }
    asm volatile("s_waitcnt lgkmcnt(0)" ::: "memory");
#pragma unroll
    for (int i = 0; i < 4; ++i) {
        const int row = (lane >> 3) + 8 * i, c = lane & 7;
        const u32x4 w = *(const LAS u32x4*)(ost + row * 144 + c * 16);
        *(GAS u32x4*)(base + (size_t)((q0 + row) * dil + rw) * NQKV + c * 8) = w;
    }
    if (hh == 0) lse[((size_t)bl * SEQ + tq) * 48 + g * 16 + h] = m * 0.125f + __logf(lsum);
    asm volatile("s_waitcnt lgkmcnt(0)" ::: "memory"); __builtin_amdgcn_s_barrier(); asm volatile("" ::: "memory");
}

#define XB_TMO      128
#define XB_XCNT(j)  (256  + 64 * (j))
#define XB_XSUB(j)  (1280 + 64 * (j))
#define XB_XGEN(j)  (2304 + 64 * (j))
#define XB_TOP      3328
#define XB_TOPGEN   3392
#define XCD_BAR_WORDS 3456
#define XB_SPIN_CAP (1u << 18)

__device__ __forceinline__ unsigned xb_ld(unsigned* p)              { return __hip_atomic_load(p, __ATOMIC_RELAXED, __HIP_MEMORY_SCOPE_AGENT); }
__device__ __forceinline__ unsigned xb_add(unsigned* p, unsigned v) { return __hip_atomic_fetch_add(p, v, __ATOMIC_RELAXED, __HIP_MEMORY_SCOPE_AGENT); }
__device__ __forceinline__ unsigned xb_xcc_id() { return (unsigned)__builtin_amdgcn_s_getreg((3 << 11) | 20) & 0xFu; }
#define XB_SPIN(cond, bar) do { unsigned _sp = 0; while (cond) { __builtin_amdgcn_s_sleep(1); \
    if ((++_sp & 255u) == 0u) { if (xb_ld(&(bar)[XB_TMO])) break; if (_sp > XB_SPIN_CAP) { atomicAdd(&(bar)[XB_TMO], 1u); break; } } } } while (0)

struct XcdBarrier {
    unsigned* bar; unsigned x;
    volatile LAS unsigned* st;
};

__device__ __forceinline__ XcdBarrier xcd_barrier_post(unsigned* bar, volatile LAS unsigned* st) {
    XcdBarrier b; b.bar = bar; b.x = xb_xcc_id(); b.st = st;
    if (threadIdx.x == 0) (void)xb_add(&bar[XB_XCNT(b.x)], 1u);
    return b;
}
__device__ __forceinline__ void xcd_barrier_complete(unsigned* bar, unsigned x, unsigned& nloc, unsigned& nx) {
    const unsigned G = gridDim.x * gridDim.y * gridDim.z;
    unsigned sum, cnt, mine, sp = 0u;
    for (;;) {
        sum = 0u; cnt = 0u; mine = 0u;
#pragma unroll
        for (unsigned j = 0; j < 16; ++j) { const unsigned c = xb_ld(&bar[XB_XCNT(j)]); sum += c; cnt += (c > 0u) ? 1u : 0u; mine = (j == x) ? c : mine; }
        if (sum == G) break;
        __builtin_amdgcn_s_sleep(1);
        if ((++sp & 255u) == 0u) { if (xb_ld(&bar[XB_TMO])) break; if (sp > XB_SPIN_CAP) { atomicAdd(&bar[XB_TMO], 1u); break; } }
    }
    nloc = mine > 0u ? mine : 1u; nx = cnt > 0u ? cnt : 1u;
}

__device__ __forceinline__ void xcd_barrier(const XcdBarrier& b) {
    asm volatile("s_waitcnt vmcnt(0)" ::: "memory");
    __syncthreads();
    if (threadIdx.x == 0) {
        unsigned* bar = b.bar;
        __builtin_amdgcn_s_waitcnt(0);
        unsigned nloc = b.st[0], nx = b.st[1];
        if (nloc == 0u) { xcd_barrier_complete(bar, b.x, nloc, nx); b.st[0] = nloc; b.st[1] = nx; }
        const unsigned old = xb_add(&bar[XB_XSUB(b.x)], 1u);
        const unsigned gen = old / nloc;
        if (old + 1u == (gen + 1u) * nloc) {
            __builtin_amdgcn_fence(__ATOMIC_RELEASE, "agent");
            asm volatile("s_waitcnt vmcnt(0)" ::: "memory");
            const unsigned og = xb_add(&bar[XB_TOP], 1u);
            const unsigned tg = og / nx;
            if (og + 1u == (tg + 1u) * nx) xb_add(&bar[XB_TOPGEN], 1u);
            else XB_SPIN(xb_ld(&bar[XB_TOPGEN]) == tg, bar);
            __builtin_amdgcn_fence(__ATOMIC_ACQUIRE, "agent");
            xb_add(&bar[XB_XGEN(b.x)], 1u);
            asm volatile("s_waitcnt vmcnt(0)" ::: "memory");
        } else {
            XB_SPIN(xb_ld(&bar[XB_XGEN(b.x)]) == gen, bar);
            __builtin_amdgcn_fence(__ATOMIC_ACQUIRE, "agent");
            asm volatile("s_waitcnt vmcnt(0)" ::: "memory");
        }
    }
    __syncthreads();
}

#define XL_ARR(x) (4096 + 64 * (x))
#define XL_GEN(x) (5120 + 64 * (x))
#define XL_WORDS 6144
__device__ __forceinline__ void xcd_local_barrier(unsigned* bar, unsigned x) {
    asm volatile("s_waitcnt vmcnt(0)" ::: "memory");
    __syncthreads();
    if (threadIdx.x == 0) {
        const unsigned old = xb_add(&bar[XL_ARR(x)], 1u), gen = old / 32u;
        if (old + 1u == (gen + 1u) * 32u) xb_add(&bar[XL_GEN(x)], 1u);
        else XB_SPIN(xb_ld(&bar[XL_GEN(x)]) == gen, bar);
        __builtin_amdgcn_fence(__ATOMIC_ACQUIRE, "agent");
        asm volatile("s_waitcnt vmcnt(0)" ::: "memory");
    }
    __syncthreads();
}

__global__ void __launch_bounds__(512, 2) mk_fwd(Args args) {
    extern __shared__ __attribute__((aligned(16))) unsigned char lds_raw[];
    LAS unsigned char* lds = (LAS unsigned char*)lds_raw;
    const int tid = threadIdx.x, lane = tid & 63, wave = __builtin_amdgcn_readfirstlane(tid >> 6);
    const int G = gridDim.x, bx = blockIdx.x, NGW = G * 8;
    int vbx = bx, gw = bx * 8 + wave;
    typedef const Args __attribute__((address_space(4))) CArgs;
#define AP() ({ CArgs* p_ = (CArgs*)__builtin_amdgcn_kernarg_segment_ptr(); asm volatile("" : "+s"(p_)); p_; })
#define x_in ((const float*)AP()->in[0])
#define c_in ((const float*)AP()->in[1])
#define w_qkv ((const float*)AP()->in[2])
#define w_o ((const float*)AP()->in[3])
#define w_cin ((const float*)AP()->in[4])
#define w_conv ((const float*)AP()->in[5])
#define w_cout ((const float*)AP()->in[6])
#define ada_w ((const float*)AP()->in[7])
#define ada_b ((const float*)AP()->in[8])
#define nmix_g ((const float*)AP()->in[9])
#define nffn_g ((const float*)AP()->in[10])
#define w_fin ((const float*)AP()->in[11])
#define w_fout ((const float*)AP()->in[12])
#define final_g ((const float*)AP()->in[13])
#define out ((float*)AP()->out)
#define ws ((unsigned char*)AP()->ws)
#define mod ((float*)(ws + WS_MOD))
#define rope ((float*)(ws + WS_ROPE))
#define Wqkv_t ((bf16_t*)(ws + WS_WQKV))
#define Wo_t ((bf16_t*)(ws + WS_WO))
#define Cin_t ((bf16_t*)(ws + WS_CIN))
#define Cout_t ((bf16_t*)(ws + WS_COUT))
#define H ((bf16_t*)(ws + WS_H))
#define O ((bf16_t*)(ws + WS_O))
#define LSE ((float*)(ws + WS_LSE))
#define BIG ((bf16_t*)(ws + WS_BIG))
#define BCU ((bf16_t*)(ws + WS_BIG + ((AP()->flags & 1) ? BCU_OFF : 0)))
#define ssq ((GAS float*)(ws + WS_SSQ))
#define bias_cin ((float*)(ws + WS_BIASV))
#define bias_fin (bias_cin + 16 * 3 * DM)
#define mod0 ((const float*)mod)
#define mod1 ((const float*)mod + 16 * MODW)
    const int nchunk = args.nchunk, MC = MTOK / nchunk;
    volatile LAS unsigned* bst = (volatile LAS unsigned*)(lds + LDS_BYTES - 16);
    unsigned* barw = (unsigned*)(ws + WS_BAR);
    if (tid < 2) bst[tid] = 0u;
    if (tid == 0) { const unsigned x_ = xb_xcc_id(); bst[3] = x_; bst[2] = xb_add(&barw[x_], 1u); }
    __syncthreads();
    const int xcc = __builtin_amdgcn_readfirstlane((int)bst[3]), xrank = __builtin_amdgcn_readfirstlane((int)bst[2]);
    const XcdBarrier xbar = xcd_barrier_post(barw, bst);

    {
        for (int item = bx; item < 192; item += G) { const int layer = item / 96, cb = item % 96;
            gemv16_item((GAS const float*)c_in, DM, true, (GAS const float*)ada_w + (size_t)layer * DM * MODW, MODW, cb, (GAS const float*)ada_b + layer * MODW, (GAS float*)mod + (size_t)layer * 16 * MODW, lds, tid, wave, lane); }
        __syncthreads();
        LAS float* scr = (LAS float*)(lds + wave * 16384);
        constexpr int I_QKV = 16 * 288, I_O = 16 * 32, I_CIN = 16 * 96, I_CO = 16 * 32, I_FIN = 16 * 176, I_FOUT = 44 * 32;
        constexpr int NITEMS = I_QKV + I_O + I_CIN + I_CO + 2 * I_FIN + 2 * I_FOUT;
        constexpr int POOL_A = 10600;
        const bool split = (G == 256);
        const int it0 = split ? (bx < 192 ? gw : POOL_A + (gw - 192 * 8)) : gw, itend = split ? (bx < 192 ? POOL_A : NITEMS) : NITEMS, itstep = split ? (bx < 192 ? 192 * 8 : 64 * 8) : NGW;
        for (int it = it0; it < itend; it += itstep) {
            int q = it;
            if (q < I_QKV) { const int kb = q / 288, nb = q % 288; p0_transpose_item(w_qkv, DM, NQKV, Wqkv_t, 64 * kb, 32 * nb, 32 * nb, scr, lane); continue; } q -= I_QKV;
            if (q < I_O) { const int kb = q / 32, nb = q % 32; p0_transpose_item(w_o, DM, DM, Wo_t, 64 * kb, 32 * nb, 32 * nb, scr, lane); continue; } q -= I_O;
            if (q < I_CIN) { const int kb = q / 96, nb = q % 96, n0 = 32 * nb;
                const int j0 = n0 < DM ? n0 : (n0 < 2 * DM ? n0 - DM : n0 - 2 * DM); const int drow = n0 < DM ? n0 : DM + 256 * (j0 >> 7) + (n0 < 2 * DM ? 0 : 128) + (j0 & 127);
                p0_transpose_item(w_cin, DM, 3 * DM, Cin_t, 64 * kb, n0, drow, scr, lane); continue; } q -= I_CIN;
            if (q < I_CO) { const int kb = q / 32, nb = q % 32; p0_transpose_item(w_cout, DM, DM, Cout_t, 64 * kb, 32 * nb, 32 * nb, scr, lane); continue; } q -= I_CO;
            if (q < 2 * I_FIN) { const int l = q / I_FIN; q -= l * I_FIN; const int kb = q / 176, nb = q % 176; const int n0 = 32 * nb;
                const int j0 = n0 < FF ? n0 : n0 - FF; const int drow = 256 * (j0 >> 7) + (n0 < FF ? 0 : 128) + (j0 & 127);
                p0_transpose_item(w_fin + (size_t)l * DM * 2 * FF, DM, 2 * FF, (bf16_t*)(ws + WS_FIN + l * FIN_BYTES), 64 * kb, n0, drow, scr, lane); continue; } q -= 2 * I_FIN;
            { const int l = q / I_FOUT; q -= l * I_FOUT; const int kb = q / 32, nb = q % 32;
                p0_transpose_item(w_fout + (size_t)l * FF * DM, FF, DM, (bf16_t*)(ws + WS_FOUT + l * FOUT_BYTES), 64 * kb, 32 * nb, 32 * nb, scr, lane); }
        }
        for (int idx = bx * 512 + tid; idx < SEQ * 8; idx += G * 512) {
            const int pos = idx >> 3, j = idx & 7;
            const float inv = exp2f(-(float)j * 0.125f * 18.931568569324174f);
            const float ang = (float)pos * inv;
            double rev = (double)ang * 0.15915494309189535; rev -= floor(rev);
            const float f = (float)rev;
            rope[pos * 16 + j] = __builtin_amdgcn_cosf(f); rope[pos * 16 + 8 + j] = __builtin_amdgcn_sinf(f);
        }
        __syncthreads();
        for (int i = bx * 512 + tid; i < 4 * MTOK; i += G * 512) ssq[i] = 0.f;
    }
    xcd_barrier(xbar);
    bool local = (AP()->flags & 1) && G == 256 && nchunk <= 2;
    { unsigned okc = 0;
#pragma unroll
      for (int j = 0; j < 8; ++j) okc += (xb_ld(&barw[j]) == 32u) ? 1u : 0u;
      local = local && (__builtin_amdgcn_readfirstlane((int)okc) == 8) && xcc < 8 && xrank < 32; }
    if (local) { vbx = xrank * 8 + xcc; gw = vbx * 8 + wave; }
    const int xl = vbx & 7, rk8 = (vbx >> 3) * 8 + wave;
#define SEAM() do { if (local) xcd_local_barrier(barw, (unsigned)xcc); else xcd_barrier(xbar); } while (0)
#define XLOOP(i, total) for (int i = local ? xl * ((total) / 8) + rk8 : gw, i##_e = local ? (xl + 1) * ((total) / 8) : (total), i##_s = local ? 256 : NGW; i < i##_e; i += i##_s)

    {
        for (int item = bx; item < 224; item += G) {
            if (item < 48) gemv16_item((GAS const float*)mod1, MODW, false, (GAS const float*)w_cin, 3 * DM, item, nullptr, (GAS float*)bias_cin, lds, tid, wave, lane);
            else { const int l = (item - 48) / 88, cb = (item - 48) % 88;
                gemv16_item((GAS const float*)(l ? mod1 : mod0) + 3 * DM, MODW, false, (GAS const float*)w_fin + (size_t)l * DM * 2 * FF, 2 * FF, cb, nullptr, (GAS float*)bias_fin + (size_t)l * 16 * 2 * FF, lds, tid, wave, lane); }
        }
    }
    if (local) norm_rows(x_in, nmix_g, mod0, 0, DM, H, xl * (MTOK / 8), (xl + 1) * (MTOK / 8), rk8, 256, lane);
    else norm_rows(x_in, nmix_g, mod0, 0, DM, H, 0, MTOK, gw, NGW, lane);
    SEAM();
    for (int ch = 0; ch < nchunk; ++ch) {
        const int row0 = ch * MC, ilv = (nchunk == 2) ? 1 : 0;
        {
            pg8::Gemm g{ilv ? H : H + (size_t)row0 * DM, Wqkv_t, MC, NQKV, DM, ilv, ch}; pg8::StaticOrder S; S.init(MC, NQKV, G, vbx);
            pg8::EpiBf16 E{opq(BIG), NQKV, nullptr, nullptr, 0};
            pg8::gemm_phase<pg8::EpiBf16, pg8::StaticOrder>(lds, g, S, E);
        }
        SEAM();
        {
            const int nunits = (MC / SEQ) * 384;
            GAS bf16_t* qkvp = opq(BIG); GAS float* lsep = opq(LSE); GAS const float* ropep = opq((const float*)rope); int tl = tid; asm volatile("" : "+v"(tl));
            const int u0 = local ? xl * (nunits / 8) + (vbx >> 3) : vbx, ue = local ? (xl + 1) * (nunits / 8) : nunits, us = local ? 32 : G;
            if (u0 < ue) {
                AttnPre R; attn_prefetch(qkvp, u0, tl, wave, tl & 63, R);
                for (int U = u0; U < ue; U += us) attn_unit(qkvp, lsep, lds, U, U + us < ue ? U + us : U, tl, wave, tl & 63, R);
            }
            asm volatile("s_waitcnt vmcnt(0)" ::: "memory");
        }
        SEAM();
        {
            GAS const float* lsep = opq(LSE); GAS const bf16_t* qkvp = opq(BIG); GAS bf16_t* Op = opq(O); int ln = lane; asm volatile("" : "+v"(ln));
            XLOOP(tok, MC) {
                const int hd = ln >> 2;
                const float l0 = lsep[(size_t)tok * 48 + hd], l1 = lsep[(size_t)tok * 48 + 16 + hd], l2 = lsep[(size_t)tok * 48 + 32 + hd];
                const float mx = fmaxf(l0, fmaxf(l1, l2));
                float w0 = __expf(l0 - mx), w1 = __expf(l1 - mx), w2 = __expf(l2 - mx);
                const float inv = __builtin_amdgcn_rcpf(w0 + w1 + w2); w0 *= inv; w1 *= inv; w2 *= inv;
                GAS const bf16_t* src = qkvp + (size_t)tok * NQKV + ln * 16;
                float acc[16];
#pragma unroll
                for (int i = 0; i < 16; ++i) acc[i] = 0.f;
#pragma unroll
                for (int gg = 0; gg < 3; ++gg) { const float wg = gg == 0 ? w0 : (gg == 1 ? w1 : w2);
                    const u32x4 a = *(GAS const u32x4*)(src + gg * 3072), b = *(GAS const u32x4*)(src + gg * 3072 + 8);
#pragma unroll
                    for (int i = 0; i < 4; ++i) { acc[2 * i] += wg * bf_lo(a[i]); acc[2 * i + 1] += wg * bf_hi(a[i]); acc[8 + 2 * i] += wg * bf_lo(b[i]); acc[9 + 2 * i] += wg * bf_hi(b[i]); } }
                u32x4 o0, o1;
#pragma unroll
                for (int i = 0; i < 4; ++i) { o0[i] = pk2(acc[2 * i], acc[2 * i + 1]); o1[i] = pk2(acc[8 + 2 * i], acc[9 + 2 * i]); }
                GAS bf16_t* dst = Op + (size_t)(ilv ? (((tok >> 11) * 2 + ch) << 11) + (tok & (SEQ - 1)) : row0 + tok) * DM + ln * 16;
                *(GAS u32x4*)dst = o0; *(GAS u32x4*)(dst + 8) = o1;
            }
        }
        SEAM();
        {
            pg8::Gemm g{ilv ? O : O + (size_t)row0 * DM, Wo_t, MC, DM, DM, ilv, ch}; pg8::StaticOrder S; S.init(MC, DM, G, vbx);
            pg8::EpiResid E{opq(x_in), nullptr, nullptr, opq(mod0 + 2 * DM), opq(nffn_g), opq(mod0 + 4 * DM), opq(H), ssq, row0 / 256, ilv, ch};
            pg8::gemm_phase<pg8::EpiResid, pg8::StaticOrder>(lds, g, S, E);
        }
        if (ch == nchunk - 1) xcd_barrier(xbar);
    }
    for (int layer = 0; layer < 2; ++layer) {
#define modl (layer ? mod1 : mod0)
        if (layer == 1) {
            {
                pg8::Gemm g{H, Cin_t, MTOK, 3 * DM, DM, 0, 0}; pg8::StaticOrder S; S.init(MTOK, 3 * DM, G, vbx);
                pg8::EpiConvIn E{opq(BCU), opq(BCU + (size_t)MTOK * DM), ssq + MTOK, opq((const float*)bias_cin)};
                pg8::gemm_phase<pg8::EpiConvIn, pg8::StaticOrder>(lds, g, S, E);
            }
            SEAM();
            {
                GAS const bf16_t* bgp = opq(BCU); GAS const bf16_t* cup = opq(BCU + (size_t)MTOK * DM); GAS bf16_t* Zp = opq(O); GAS const float* wcv = opq(w_conv); int ln = lane; asm volatile("" : "+v"(ln));
                XLOOP(item, (MTOK / 16) * 2) {
                    const int rb = item >> 1, col = (item & 1) * 512 + ln * 8, t0 = rb * 16;
                    float wk[3][8];
#pragma unroll
                    for (int k = 0; k < 3; ++k) { const f32x4 a = *(GAS const f32x4*)(wcv + k * DM + col), b = *(GAS const f32x4*)(wcv + k * DM + col + 4);
                        wk[k][0] = a.x; wk[k][1] = a.y; wk[k][2] = a.z; wk[k][3] = a.w; wk[k][4] = b.x; wk[k][5] = b.y; wk[k][6] = b.z; wk[k][7] = b.w; }
                    float prev[8], cur[8], nxt[8];
#define LOAD_CU(t, d) do { const u32x4 cu_ = *(GAS const u32x4*)(cup + (size_t)(t) * DM + col); \
                        _Pragma("unroll") for (int i_ = 0; i_ < 4; ++i_) { d[2 * i_] = bf_lo(cu_[i_]); d[2 * i_ + 1] = bf_hi(cu_[i_]); } } while (0)
                    if ((t0 & (SEQ - 1)) == 0) {
#pragma unroll
                        for (int i = 0; i < 8; ++i) prev[i] = 0.f;
                    } else LOAD_CU(t0 - 1, prev);
                    LOAD_CU(t0, cur);
#pragma unroll 4
                    for (int i = 0; i < 16; ++i) {
                        const int t = t0 + i;
                        if ((t & (SEQ - 1)) == SEQ - 1) {
#pragma unroll
                            for (int e2 = 0; e2 < 8; ++e2) nxt[e2] = 0.f;
                        } else LOAD_CU(t + 1, nxt);
                        const u32x4 bb = *(GAS const u32x4*)(bgp + (size_t)t * DM + col);
                        float z[8];
#pragma unroll
                        for (int e2 = 0; e2 < 8; ++e2) z[e2] = wk[0][e2] * prev[e2] + wk[1][e2] * cur[e2] + wk[2][e2] * nxt[e2];
                        u32x4 w;
#pragma unroll
                        for (int e2 = 0; e2 < 4; ++e2) w[e2] = pk2(bf_lo(bb[e2]) * z[2 * e2], bf_hi(bb[e2]) * z[2 * e2 + 1]);
                        *(GAS u32x4*)(Zp + (size_t)t * DM + col) = w;
#pragma unroll
                        for (int e2 = 0; e2 < 8; ++e2) { prev[e2] = cur[e2]; cur[e2] = nxt[e2]; }
                    }
#undef LOAD_CU
                }
            }
            SEAM();
            {
                pg8::Gemm g{O, Cout_t, MTOK, DM, DM, 0, 0}; pg8::StaticOrder S; S.init(MTOK, DM, G, vbx);
                pg8::EpiResid E{nullptr, opq(nmix_g + DM), opq(mod1 + DM), opq(modl + 2 * DM), opq(nffn_g + DM), opq(modl + 4 * DM), opq(H), ssq + 2 * MTOK, 0, 0, 0};
                pg8::gemm_phase<pg8::EpiResid, pg8::StaticOrder>(lds, g, S, E);
            }
            SEAM();
        }
        {
            pg8::Gemm g{H, (const bf16_t*)(ws + WS_FIN + layer * FIN_BYTES), MTOK, 2 * FF, DM, 0, 0}; pg8::StaticOrder S; S.init(MTOK, 2 * FF, G, vbx);
            pg8::EpiSwiGLU E{opq(BIG), FF, ssq + (layer ? 2 * MTOK : 0), opq((const float*)bias_fin + (size_t)layer * 16 * 2 * FF)};
            pg8::gemm_phase<pg8::EpiSwiGLU, pg8::StaticOrder>(lds, g, S, E);
        }
        SEAM();
        {
            pg8::Gemm g{BIG, (const bf16_t*)(ws + WS_FOUT + layer * FOUT_BYTES), MTOK, DM, FF, 0, 0}; pg8::StaticOrder S; S.init(MTOK, DM, G, vbx);
            pg8::EpiResid E{nullptr, opq(nffn_g + layer * DM), opq(modl + 4 * DM), opq(modl + 5 * DM), layer ? opq(final_g) : opq(nmix_g + DM), layer ? (GAS const float*)nullptr : opq(mod1 + DM), opq(H), ssq + (layer ? 3 * MTOK : MTOK), 0, 0, 0};
            pg8::gemm_phase<pg8::EpiResid, pg8::StaticOrder>(lds, g, S, E);
        }
        SEAM();
    }
    {
        GAS float* op = opq(out); GAS const bf16_t* hp = opq((const bf16_t*)H); GAS const float* sq = ssq + 3 * MTOK; int ln = lane; asm volatile("" : "+v"(ln));
        XLOOP(row, MTOK) {
            const float rstd = rsqrtf(sq[row] * (1.f / DM) + EPS);
#pragma unroll
            for (int j = 0; j < 2; ++j) {
                const u32x4 h = *(GAS const u32x4*)(hp + (size_t)row * DM + 512 * j + 8 * ln);
                GAS f32x4* o = (GAS f32x4*)(op + (size_t)row * DM + 512 * j + 8 * ln);
                o[0] = (f32x4){bf_lo(h.x) * rstd, bf_hi(h.x) * rstd, bf_lo(h.y) * rstd, bf_hi(h.y) * rstd};
                o[1] = (f32x4){bf_lo(h.z) * rstd, bf_hi(h.z) * rstd, bf_lo(h.w) * rstd, bf_hi(h.w) * rstd};
            }
        }
    }
}

#undef AP
#undef x_in
#undef c_in
#undef w_qkv
#undef w_o
#undef w_cin
#undef w_conv
#undef w_cout
#undef ada_w
#undef ada_b
#undef nmix_g
#undef nffn_g
#undef w_fin
#undef w_fout
#undef final_g
#undef out
#undef ws
#undef mod
#undef rope
#undef Wqkv_t
#undef Wo_t
#undef Cin_t
#undef Cout_t
#undef H
#undef O
#undef LSE
#undef BIG
#undef BCU
#undef SEAM
#undef XLOOP
#undef ssq
#undef bias_cin
#undef bias_fin
#undef mod0
#undef mod1
#undef modl
extern "C" void kernel_launch(void* const* d_in, const int* in_sizes, int n_in, void* d_out, int out_size, void* d_ws, size_t ws_size, hipStream_t stream) {
    static int grid = 0; static int nchunk = 0; static int flags = 0;
    if (grid == 0) {
        int dev = 0, cus = 0, per_cu = 0;
        if (hipGetDevice(&dev) != hipSuccess || hipDeviceGetAttribute(&cus, hipDeviceAttributeMultiprocessorCount, dev) != hipSuccess) { fprintf(stderr, "kernel_launch: device query failed\n"); grid = -1; return; }
        if (hipFuncSetAttribute((const void*)mk_fwd, hipFuncAttributeMaxDynamicSharedMemorySize, LDS_BYTES) != hipSuccess) { fprintf(stderr, "kernel_launch: hipFuncSetAttribute failed\n"); grid = -1; return; }
        if (hipOccupancyMaxActiveBlocksPerMultiprocessor(&per_cu, (const void*)mk_fwd, 512, LDS_BYTES) != hipSuccess || per_cu < 1) { fprintf(stderr, "kernel_launch: occupancy query says %d blocks/CU\n", per_cu); (void)hipGetLastError(); grid = -1; return; }
        grid = cus;
        const size_t need1 = WS_BIG + (size_t)MTOK * NQKV * 2, need2 = WS_BIG + (size_t)(MTOK / 2) * NQKV * 2, need4 = WS_BIG + (size_t)MTOK * 3 * DM * 2;
        nchunk = ws_size >= need1 ? 1 : (ws_size >= need2 ? 2 : 4);
        flags = (ws_size >= WS_BIG + BCU_OFF + (size_t)2 * MTOK * DM * 2) ? 1 : 0;
        if (ws_size < need4) { fprintf(stderr, "kernel_launch: workspace too small (%zu < %zu)\n", ws_size, need4); grid = -1; return; }
    }
    if (grid < 0) return;
    Args a{};
    for (int i = 0; i < 14; ++i) a.in[i] = (const float*)d_in[i];
    a.out = (float*)d_out; a.ws = (unsigned char*)d_ws; a.nchunk = nchunk; a.flags = flags;
    if (hipMemsetAsync((char*)d_ws + WS_BAR, 0, XL_WORDS * 4, stream) != hipSuccess) { fprintf(stderr, "kernel_launch: memset of the barrier words failed\n"); return; }
    void* kargs[] = {&a};
    hipError_t e = hipLaunchCooperativeKernel((const void*)mk_fwd, dim3(grid), dim3(512), kargs, LDS_BYTES, stream);
    if (e != hipSuccess) fprintf(stderr, "kernel_launch: cooperative launch failed: %s (grid %d)\n", hipGetErrorString(e), grid);
}
```

```cpp
#include <hip/hip_runtime.h>
#include <hip/hip_cooperative_groups.h>
#include <cstdio>
#include <cstdint>
namespace cg = cooperative_groups;

#define LAS __attribute__((address_space(3)))
#define GAS __attribute__((address_space(1)))
typedef unsigned short bf16_t;
typedef short bf16x8 __attribute__((ext_vector_type(8)));
typedef short s16x4 __attribute__((ext_vector_type(4)));
typedef float f32x4 __attribute__((ext_vector_type(4)));
typedef float f32x16 __attribute__((ext_vector_type(16)));
typedef unsigned u32x4 __attribute__((ext_vector_type(4)));
typedef unsigned u32x2 __attribute__((ext_vector_type(2)));

__device__ __forceinline__ unsigned pk2(float lo, float hi) {
    typedef __bf16 b2 __attribute__((ext_vector_type(2)));
    b2 v; v.x = (__bf16)lo; v.y = (__bf16)hi; return __builtin_bit_cast(unsigned, v);
}
template <class T> __device__ __forceinline__ GAS T* opq(T* p) { asm volatile("" : "+s"(p)); return (GAS T*)p; }
__device__ __forceinline__ float bf_lo(unsigned u) { return __uint_as_float(u << 16); }
__device__ __forceinline__ float bf_hi(unsigned u) { return __uint_as_float(u & 0xffff0000u); }

constexpr int DM = 1024, NB = 16, SEQ = 2048, MTOK = NB * SEQ, FF = 2816, NQKV = 9216, MODW = 6 * DM;
constexpr float EPS = 1e-6f;

namespace pg8 {
constexpr int BM = 256, BK = 64, HALF = 128, HTB = HALF * BK * 2, STAGE_BYTES = 8 * HTB, NXCD = 8, WGM = 8;
__host__ __device__ __forceinline__ int lds_byte(int r, int c) { const int st = (r >> 4) * 2 + (c >> 5), rr = r & 15, cc = c & 31, ob = rr * 64 + cc * 2; return st * 1024 + (ob ^ (((ob >> 9) & 1) << 5)); }
__host__ __device__ __forceinline__ void stage_rc(int b, int& R, int& C) { const int st = b / 1024, sb = b % 1024, swz = sb ^ (((sb >> 9) & 1) << 5); R = (st >> 1) * 16 + swz / 64; C = (st & 1) * 32 + (swz % 64) / 2; }
__host__ __device__ __forceinline__ int perm32(int rho) { const int n = rho >> 4, i = rho & 15; return 8 * (i >> 2) + 4 * n + (i & 3); }

struct Unit { int pm, pn; };
struct Gemm { const bf16_t* A; const bf16_t* Bt; int M, N, K; int ilv, ch; };

struct StaticOrder {
    int nM, nN, nwg, G, c;
    __device__ void init(int M, int N, int G_, int c_) { nM = M / BM; nN = N / BM; nwg = nM * nN; G = G_; c = c_; }
    __device__ bool next(int i, Unit& u) const {
        const long L = (long)i * G + c; if (L >= nwg) return false;
        int wgid = (int)L; { const int q = nwg / NXCD, r = nwg % NXCD, xcd = wgid % NXCD, off = wgid / NXCD; wgid = (xcd < r ? xcd * (q + 1) : r * (q + 1) + (xcd - r) * q) + off; }
        const int nig = WGM * nN, gid = wgid / nig, fm = gid * WGM, gsz = (nM - fm) < WGM ? (nM - fm) : WGM;
        u.pm = fm + ((wgid % nig) % gsz); u.pn = (wgid % nig) / gsz; return true;
    }
    __device__ __forceinline__ void a_ready(const Unit&) const {}
    __device__ __forceinline__ void done(const Unit&) const {}
};

struct EpiBf16 {
    static constexpr bool PERM = true;
    GAS bf16_t* O; int ldc; GAS const float* ssq; GAS const float* bias; int nb;
    __device__ __forceinline__ void operator()(const f32x4 (&acc)[2][2][4][2], const Unit& u, int wr, int wc, int fr, int fq) const {
        const int row0 = u.pm * BM + wr * 64 + fr, col0 = u.pn * BM + wc * 32 + 8 * fq;
        f32x4 bv[2][2];
#pragma unroll
        for (int bj = 0; bj < 2; ++bj)
#pragma unroll
            for (int n = 0; n < 2; ++n) bv[bj][n] = ssq ? *(GAS const f32x4*)(bias + (size_t)((u.pm * BM) >> 11) * nb + col0 + bj * HALF + 4 * n) : (f32x4){0.f, 0.f, 0.f, 0.f};
#pragma unroll
        for (int ai = 0; ai < 2; ++ai)
#pragma unroll
            for (int m = 0; m < 4; ++m) { GAS bf16_t* rowp = O + (size_t)(row0 + ai * HALF + m * 16) * ldc + col0;
                const float rs = ssq ? __builtin_amdgcn_rsqf(ssq[row0 + ai * HALF + m * 16] * (1.f / DM) + EPS) : 1.f;
#pragma unroll
                for (int bj = 0; bj < 2; ++bj) { const f32x4 v0 = acc[ai][bj][m][0] * rs + bv[bj][0], v1 = acc[ai][bj][m][1] * rs + bv[bj][1];
                    u32x4 w; w.x = pk2(v0[0], v0[1]); w.y = pk2(v0[2], v0[3]); w.z = pk2(v1[0], v1[1]); w.w = pk2(v1[2], v1[3]);
                    *(GAS u32x4*)(rowp + bj * HALF) = w; } }
    }
};
__device__ __forceinline__ float silu_mul(float g, float u) { return g * __builtin_amdgcn_rcpf(1.0f + __expf(-g)) * u; }
struct EpiSwiGLU {
    static constexpr bool PERM = true;
    GAS bf16_t* O; int ldc; GAS const float* ssq; GAS const float* bias;
    __device__ __forceinline__ void operator()(const f32x4 (&acc)[2][2][4][2], const Unit& u, int wr, int wc, int fr, int fq) const {
        const int row0 = u.pm * BM + wr * 64 + fr, col0 = u.pn * HALF + wc * 32 + 8 * fq;
        GAS const float* bp = bias + (size_t)((u.pm * BM) >> 11) * (2 * FF) + col0;
        const f32x4 bg0 = *(GAS const f32x4*)(bp), bg1 = *(GAS const f32x4*)(bp + 4), bu0 = *(GAS const f32x4*)(bp + FF), bu1 = *(GAS const f32x4*)(bp + FF + 4);
        const f32x4 nbg0 = bg0 * -1.44269504088896f, nbg1 = bg1 * -1.44269504088896f;
#pragma unroll
        for (int ai = 0; ai < 2; ++ai)
#pragma unroll
            for (int m = 0; m < 4; ++m) { GAS bf16_t* rowp = O + (size_t)(row0 + ai * HALF + m * 16) * ldc + col0;
                const float rs = __builtin_amdgcn_rsqf(ssq[row0 + ai * HALF + m * 16] * (1.f / DM) + EPS);
                const float nrs = rs * -1.44269504088896f;
                const f32x4 g0 = acc[ai][0][m][0] * rs + bg0, g1 = acc[ai][0][m][1] * rs + bg1, u0 = acc[ai][1][m][0] * rs + bu0, u1 = acc[ai][1][m][1] * rs + bu1;
                const f32x4 t0 = acc[ai][0][m][0] * nrs + nbg0, t1 = acc[ai][0][m][1] * nrs + nbg1;
                f32x4 e0, e1;
#pragma unroll
                for (int i = 0; i < 4; ++i) e0[i] = __builtin_amdgcn_exp2f(t0[i]);
#pragma unroll
                for (int i = 0; i < 4; ++i) e1[i] = __builtin_amdgcn_exp2f(t1[i]);
                const f32x4 d0 = e0 + 1.0f, d1 = e1 + 1.0f, gu0 = g0 * u0, gu1 = g1 * u1;
                f32x4 r0, r1;
#pragma unroll
                for (int i = 0; i < 4; ++i) r0[i] = __builtin_amdgcn_rcpf(d0[i]);
#pragma unroll
                for (int i = 0; i < 4; ++i) r1[i] = __builtin_amdgcn_rcpf(d1[i]);
                const f32x4 o0 = gu0 * r0, o1 = gu1 * r1;
                u32x4 w; w.x = pk2(o0[0], o0[1]); w.y = pk2(o0[2], o0[3]); w.z = pk2(o1[0], o1[1]); w.w = pk2(o1[2], o1[3]);
                *(GAS u32x4*)rowp = w; }
    }
};
struct EpiConvIn {
    static constexpr bool PERM = true;
    GAS bf16_t* Ob; GAS bf16_t* Ocu; GAS const float* ssq; GAS const float* bias;
    __device__ __forceinline__ void operator()(const f32x4 (&acc)[2][2][4][2], const Unit& u, int wr, int wc, int fr, int fq) const {
        const int row0 = u.pm * BM + wr * 64 + fr, bidx = (u.pm * BM) >> 11;
        if (u.pn < 4) {
            const int col0 = u.pn * BM + wc * 32 + 8 * fq;
            f32x4 bv[2][2];
#pragma unroll
            for (int bj = 0; bj < 2; ++bj)
#pragma unroll
                for (int n = 0; n < 2; ++n) bv[bj][n] = *(GAS const f32x4*)(bias + (size_t)bidx * (3 * DM) + col0 + bj * HALF + 4 * n);
#pragma unroll
            for (int ai = 0; ai < 2; ++ai)
#pragma unroll
                for (int m = 0; m < 4; ++m) { GAS bf16_t* rowp = Ob + (size_t)(row0 + ai * HALF + m * 16) * DM + col0;
                    const float rs = __builtin_amdgcn_rsqf(ssq[row0 + ai * HALF + m * 16] * (1.f / DM) + EPS);
#pragma unroll
                    for (int bj = 0; bj < 2; ++bj) { const f32x4 v0 = acc[ai][bj][m][0] * rs + bv[bj][0], v1 = acc[ai][bj][m][1] * rs + bv[bj][1];
                        u32x4 w; w.x = pk2(v0[0], v0[1]); w.y = pk2(v0[2], v0[3]); w.z = pk2(v1[0], v1[1]); w.w = pk2(v1[2], v1[3]);
                        *(GAS u32x4*)(rowp + bj * HALF) = w; } }
        } else {
            const int col0 = (u.pn - 4) * HALF + wc * 32 + 8 * fq;
            GAS const float* bp = bias + (size_t)bidx * (3 * DM) + DM + col0;
            const f32x4 bc0 = *(GAS const f32x4*)(bp), bc1 = *(GAS const f32x4*)(bp + 4), bu0 = *(GAS const f32x4*)(bp + DM), bu1 = *(GAS const f32x4*)(bp + DM + 4);
#pragma unroll
            for (int ai = 0; ai < 2; ++ai)
#pragma unroll
                for (int m = 0; m < 4; ++m) { GAS bf16_t* rowp = Ocu + (size_t)(row0 + ai * HALF + m * 16) * DM + col0;
                    const float rs = __builtin_amdgcn_rsqf(ssq[row0 + ai * HALF + m * 16] * (1.f / DM) + EPS);
                    const f32x4 p0 = (acc[ai][0][m][0] * rs + bc0) * (acc[ai][1][m][0] * rs + bu0), p1 = (acc[ai][0][m][1] * rs + bc1) * (acc[ai][1][m][1] * rs + bu1);
                    u32x4 w; w.x = pk2(p0[0], p0[1]); w.y = pk2(p0[2], p0[3]); w.z = pk2(p1[0], p1[1]); w.w = pk2(p1[2], p1[3]);
                    *(GAS u32x4*)rowp = w; }
        }
    }
};
__device__ __forceinline__ f32x4 cf_make(GAS const float* gain, GAS const float* scale, int col) {
    f32x4 c = *(GAS const f32x4*)(gain + col); if (scale) c = c * (*(GAS const f32x4*)(scale + col) + 1.0f);
#pragma unroll
    for (int i = 0; i < 4; ++i) if (fabsf(c[i]) < 1e-6f) c[i] = c[i] < 0.f ? -1e-6f : 1e-6f;
    return c;
}
struct EpiResid {
    static constexpr bool PERM = true;
    GAS const float* resid32; GAS const float* pgain; GAS const float* pscale; GAS const float* gate; GAS const float* ngain; GAS const float* nscale; GAS bf16_t* Hn; GAS float* ssq; int pbase, ilv, ch;
    __device__ __forceinline__ void operator()(const f32x4 (&acc)[2][2][4][2], const Unit& u, int wr, int wc, int fr, int fq) const {
        const int prow0 = (ilv ? (((u.pm >> 3) * 2 + ch) * 8 + (u.pm & 7)) : (pbase + u.pm)) * BM;
        const int b = prow0 >> 11;
        const int col0 = u.pn * BM + wc * 32 + 8 * fq;
        GAS const float* gp = gate + (size_t)b * MODW + col0;
        f32x4 gv[2][2], cf[2][2], rcf[2][2];
#pragma unroll
        for (int bj = 0; bj < 2; ++bj)
#pragma unroll
            for (int n = 0; n < 2; ++n) { gv[bj][n] = *(GAS const f32x4*)(gp + bj * HALF + n * 4);
                cf[bj][n] = cf_make(ngain, nscale ? nscale + (size_t)b * MODW : nullptr, col0 + bj * HALF + n * 4);
                if (!resid32) { const f32x4 pc = cf_make(pgain, pscale + (size_t)b * MODW, col0 + bj * HALF + n * 4); rcf[bj][n] = (f32x4){__builtin_amdgcn_rcpf(pc.x), __builtin_amdgcn_rcpf(pc.y), __builtin_amdgcn_rcpf(pc.z), __builtin_amdgcn_rcpf(pc.w)}; }
                else rcf[bj][n] = (f32x4){0.f, 0.f, 0.f, 0.f}; }
#pragma unroll
        for (int ai = 0; ai < 2; ++ai)
#pragma unroll
            for (int m = 0; m < 4; ++m) { const int row = prow0 + ai * HALF + wr * 64 + m * 16 + fr; const size_t off = (size_t)row * DM + col0; float s = 0.f;
#pragma unroll
                for (int bj = 0; bj < 2; ++bj) {
                    f32x4 r0, r1;
                    if (resid32) { r0 = *(GAS const f32x4*)(resid32 + off + bj * HALF); r1 = *(GAS const f32x4*)(resid32 + off + bj * HALF + 4); }
                    else { const u32x4 rr = *(GAS const u32x4*)(Hn + off + bj * HALF);
                        r0 = (f32x4){bf_lo(rr.x), bf_hi(rr.x), bf_lo(rr.y), bf_hi(rr.y)} * rcf[bj][0]; r1 = (f32x4){bf_lo(rr.z), bf_hi(rr.z), bf_lo(rr.w), bf_hi(rr.w)} * rcf[bj][1]; }
                    const f32x4 x0 = r0 + gv[bj][0] * acc[ai][bj][m][0], x1 = r1 + gv[bj][1] * acc[ai][bj][m][1];
                    s += (x0.x * x0.x + x0.y * x0.y) + (x0.z * x0.z + x0.w * x0.w) + (x1.x * x1.x + x1.y * x1.y) + (x1.z * x1.z + x1.w * x1.w);
                    const f32x4 h0 = x0 * cf[bj][0], h1 = x1 * cf[bj][1];
                    u32x4 w; w.x = pk2(h0.x, h0.y); w.y = pk2(h0.z, h0.w); w.z = pk2(h1.x, h1.y); w.w = pk2(h1.z, h1.w);
                    *(GAS u32x4*)(Hn + off + bj * HALF) = w;
                }
                s += __shfl_xor(s, 16); s += __shfl_xor(s, 32);
                if (fq == 0) __hip_atomic_fetch_add(ssq + row, s, __ATOMIC_RELAXED, __HIP_MEMORY_SCOPE_AGENT);
                if (m & 1) asm volatile("" ::: "memory"); }
    }
};

template <class Epi, class Sched, bool ALIGN_EPI = true, bool SP2 = true>
__device__ __forceinline__ void gemm_phase(LAS unsigned char* lds, const Gemm g, const Sched& S, const Epi& E) {
    int tid = threadIdx.x; asm volatile("" : "+v"(tid));
    const int wid = __builtin_amdgcn_readfirstlane(tid >> 6), lane = tid & 63, wr = wid >> 2, wc = wid & 3, fr = lane & 15, fq = lane >> 4;
    const int K = g.K, nt = K / BK;
    const char* gA = (const char*)g.A; const char* gB = (const char*)g.Bt; asm volatile("" : "+s"(gA), "+s"(gB));
    unsigned voffA[2], voffB[2];
#pragma unroll
    for (int i = 0; i < 2; ++i) { int R, C; stage_rc(tid * 16 + i * 8192, R, C); const int Rb = Epi::PERM ? ((R & ~31) + perm32(R & 31)) : R;
        voffA[i] = (unsigned)(R * K + C) * 2u; voffB[i] = (unsigned)(Rb * K + C) * 2u; }
    const size_t kstep = (size_t)(BK * 2);
    const size_t hstep = (size_t)HALF * K * 2;
    const size_t tstep = 2 * hstep;
    const unsigned ldsw = (unsigned)wid * 1024u;
    const int aoff = lds_byte(wr * 64 + fr, fq * 8), boff = lds_byte(wc * 32 + fr, fq * 8);
#define PG8_SA(b, h) (((b) * 2 + (h)) * HTB)
#define PG8_SB(b, h) ((4 + (b) * 2 + (h)) * HTB)
#define PG8_STAGE(bufoff, gbase, voff) do { _Pragma("unroll") for (int _i = 0; _i < 2; ++_i) \
        __builtin_amdgcn_global_load_lds((const unsigned*)((const char*)(gbase) + (voff)[_i]), (LAS unsigned*)(lds + (bufoff) + ldsw + _i * 8192), 16, 0, 0); } while (0)
#define PG8_LDA(dst, b, h) do { _Pragma("unroll") for (int m = 0; m < 4; ++m) _Pragma("unroll") for (int k = 0; k < 2; ++k) dst[m][k] = *(const LAS bf16x8*)(lds + PG8_SA(b, h) + aoff + m * 2048 + k * 1024); } while (0)
#define PG8_LDB(dst, b, h) do { _Pragma("unroll") for (int n = 0; n < 2; ++n) _Pragma("unroll") for (int k = 0; k < 2; ++k) dst[n][k] = *(const LAS bf16x8*)(lds + PG8_SB(b, h) + boff + n * 2048 + k * 1024); } while (0)
#define PG8_MMA(ai, bj, At, Bt) do { __builtin_amdgcn_s_setprio(1); _Pragma("unroll") for (int m = 0; m < 4; ++m) _Pragma("unroll") for (int n = 0; n < 2; ++n) _Pragma("unroll") for (int k = 0; k < 2; ++k) \
        acc[ai][bj][m][n] = __builtin_amdgcn_mfma_f32_16x16x32_bf16(Bt[n][k], At[m][k], acc[ai][bj][m][n], 0, 0, 0); __builtin_amdgcn_s_setprio(0); } while (0)
#define PG8_WAIT_V(n) asm volatile("s_waitcnt vmcnt(" #n ")" ::: "memory")
#define PG8_WAIT_L(n) asm volatile("s_waitcnt lgkmcnt(" #n ")" ::: "memory")
#define PG8_BAR __builtin_amdgcn_s_barrier()
#define PG8_SCHED __builtin_amdgcn_sched_barrier(0)
    Unit cur, nxt; int ui = 0;
    if (!S.next(0, cur)) return;
    f32x4 acc[2][2][4][2];
#pragma unroll
    for (int a = 0; a < 2; ++a)
#pragma unroll
        for (int b = 0; b < 2; ++b)
#pragma unroll
            for (int m = 0; m < 4; ++m)
#pragma unroll
                for (int n = 0; n < 2; ++n) acc[a][b][m][n] = (f32x4){0.f, 0.f, 0.f, 0.f};
    bf16x8 At[4][2], B0[2][2], B1[2][2];
#define PG8_AMAP(pm) (g.ilv ? ((((pm) >> 3) * 2 + g.ch) * 8 + ((pm) & 7)) : (pm))
    const char* cA = gA + (size_t)PG8_AMAP(cur.pm) * tstep; const char* cB = gB + (size_t)cur.pn * tstep;
    S.a_ready(cur);
    if constexpr (SP2) {
        PG8_STAGE(PG8_SB(0, 0), cB, voffB); PG8_STAGE(PG8_SB(0, 1), cB + hstep, voffB); PG8_STAGE(PG8_SA(0, 0), cA, voffA); PG8_STAGE(PG8_SA(0, 1), cA + hstep, voffA);
        if (wr == 1) PG8_BAR;
        PG8_WAIT_V(2); PG8_BAR;
        PG8_STAGE(PG8_SB(1, 0), cB + kstep, voffB); PG8_STAGE(PG8_SA(1, 0), cA + kstep, voffA); PG8_STAGE(PG8_SB(1, 1), cB + hstep + kstep, voffB);
        PG8_WAIT_V(6); PG8_BAR;
    } else {
        PG8_STAGE(PG8_SB(0, 0), cB, voffB); PG8_STAGE(PG8_SA(0, 0), cA, voffA); PG8_STAGE(PG8_SB(0, 1), cB + hstep, voffB); PG8_STAGE(PG8_SA(0, 1), cA + hstep, voffA);
        if (wr == 1) PG8_BAR;
        PG8_WAIT_V(4); PG8_BAR;
        PG8_STAGE(PG8_SB(1, 0), cB + kstep, voffB); PG8_STAGE(PG8_SA(1, 0), cA + kstep, voffA); PG8_STAGE(PG8_SB(1, 1), cB + hstep + kstep, voffB);
        PG8_WAIT_V(6); PG8_BAR;
    }
    for (;;) {
        const bool has_next = S.next(ui + 1, nxt);
        const char* nA = has_next ? gA + (size_t)PG8_AMAP(nxt.pm) * tstep : cA; const char* nB = has_next ? gB + (size_t)nxt.pn * tstep : cB;
        for (int t = 0; t < nt; t += 2) {
            const bool last = (t == nt - 2);
            const char* a1 = cA + (size_t)(t + 1) * kstep;
            const char* a2 = last ? nA : cA + (size_t)(t + 2) * kstep; const char* b2 = last ? nB : cB + (size_t)(t + 2) * kstep;
            const char* a3 = a2 + kstep; const char* b3 = b2 + kstep;
            if (last && has_next) S.a_ready(nxt);
            if constexpr (SP2) {
            PG8_LDB(B0, 0, 0); PG8_LDB(B1, 0, 1); PG8_SCHED; PG8_LDA(At, 0, 0); PG8_STAGE(PG8_SA(1, 1), a1 + hstep, voffA);
            PG8_WAIT_V(8); PG8_WAIT_L(0); PG8_BAR; PG8_MMA(0, 0, At, B0); PG8_MMA(0, 1, At, B1); PG8_BAR; PG8_SCHED;
            PG8_LDA(At, 0, 1); PG8_STAGE(PG8_SB(0, 0), b2, voffB); PG8_STAGE(PG8_SB(0, 1), b2 + hstep, voffB); PG8_STAGE(PG8_SA(0, 0), a2, voffA);
            PG8_WAIT_V(8); PG8_WAIT_L(0); PG8_BAR; PG8_MMA(1, 0, At, B0); PG8_MMA(1, 1, At, B1); PG8_BAR; PG8_SCHED;
            PG8_LDB(B0, 1, 0); PG8_LDB(B1, 1, 1); PG8_SCHED; PG8_LDA(At, 1, 0); PG8_STAGE(PG8_SA(0, 1), a2 + hstep, voffA);
            PG8_WAIT_V(8); PG8_WAIT_L(0); PG8_BAR; PG8_MMA(0, 0, At, B0); PG8_MMA(0, 1, At, B1); PG8_BAR; PG8_SCHED;
            PG8_LDA(At, 1, 1); PG8_STAGE(PG8_SB(1, 0), b3, voffB); PG8_STAGE(PG8_SB(1, 1), b3 + hstep, voffB); PG8_STAGE(PG8_SA(1, 0), a3, voffA);
            PG8_WAIT_V(8); PG8_WAIT_L(0); PG8_BAR; PG8_MMA(1, 0, At, B0); PG8_MMA(1, 1, At, B1); PG8_BAR; PG8_SCHED;
            } else {
            PG8_LDB(B0, 0, 0); PG8_SCHED; PG8_LDA(At, 0, 0); PG8_STAGE(PG8_SA(1, 1), a1 + hstep, voffA);
            PG8_WAIT_L(8); PG8_BAR; PG8_WAIT_L(0); PG8_MMA(0, 0, At, B0); PG8_BAR; PG8_SCHED;
            PG8_LDB(B1, 0, 1); PG8_STAGE(PG8_SB(0, 0), b2, voffB);
            PG8_BAR; PG8_WAIT_L(0); PG8_MMA(0, 1, At, B1); PG8_BAR;
            PG8_LDA(At, 0, 1); PG8_STAGE(PG8_SA(0, 0), a2, voffA);
            PG8_BAR; PG8_WAIT_L(0); PG8_MMA(1, 0, At, B0); PG8_BAR; PG8_SCHED;
            PG8_STAGE(PG8_SB(0, 1), b2 + hstep, voffB);
            PG8_WAIT_V(6); PG8_BAR; PG8_MMA(1, 1, At, B1); PG8_BAR;
            PG8_LDB(B0, 1, 0); PG8_SCHED; PG8_LDA(At, 1, 0); PG8_STAGE(PG8_SA(0, 1), a2 + hstep, voffA);
            PG8_WAIT_L(8); PG8_BAR; PG8_WAIT_L(0); PG8_MMA(0, 0, At, B0); PG8_BAR; PG8_SCHED;
            PG8_LDB(B1, 1, 1); PG8_STAGE(PG8_SB(1, 0), b3, voffB);
            PG8_BAR; PG8_WAIT_L(0); PG8_MMA(0, 1, At, B1); PG8_BAR;
            PG8_LDA(At, 1, 1); PG8_STAGE(PG8_SA(1, 0), a3, voffA);
            PG8_BAR; PG8_WAIT_L(0); PG8_MMA(1, 0, At, B0); PG8_BAR; PG8_SCHED;
            PG8_STAGE(PG8_SB(1, 1), b3 + hstep, voffB);
            PG8_WAIT_V(6); PG8_BAR; PG8_MMA(1, 1, At, B1); PG8_BAR;
            }
        }
        if constexpr (ALIGN_EPI) { if (wr == 0) PG8_BAR; }
        E(acc, cur, wr, wc, fr, fq); S.done(cur);
        if (!has_next) break;
#pragma unroll
        for (int a = 0; a < 2; ++a)
#pragma unroll
            for (int b = 0; b < 2; ++b)
#pragma unroll
                for (int m = 0; m < 4; ++m)
#pragma unroll
                    for (int n = 0; n < 2; ++n) acc[a][b][m][n] = (f32x4){0.f, 0.f, 0.f, 0.f};
        cur = nxt; cA = nA; cB = nB; ++ui;
        if constexpr (ALIGN_EPI) { if (wr == 1) PG8_BAR; }
    }
    PG8_WAIT_V(0);
    if constexpr (!ALIGN_EPI) { if (wr == 0) PG8_BAR; }
    PG8_BAR;
#undef PG8_AMAP
#undef PG8_SA
#undef PG8_SB
#undef PG8_STAGE
#undef PG8_LDA
#undef PG8_LDB
#undef PG8_MMA
#undef PG8_WAIT_V
#undef PG8_WAIT_L
#undef PG8_BAR
#undef PG8_SCHED
}
}

constexpr size_t MiB = 1u << 20;
constexpr size_t WS_MOD = 0;
constexpr size_t WS_ROPE = 1 * MiB;
constexpr size_t WS_WQKV = 2 * MiB;
constexpr size_t WS_WO = 20 * MiB;
constexpr size_t WS_CIN = 22 * MiB;
constexpr size_t WS_COUT = 28 * MiB;
constexpr size_t WS_FIN = 30 * MiB;
constexpr size_t WS_FOUT = 52 * MiB;
constexpr size_t WS_H = 64 * MiB;
constexpr size_t WS_O = 128 * MiB;
constexpr size_t WS_LSE = 192 * MiB;
constexpr size_t WS_SSQ = 1 * MiB + 512 * 1024;
constexpr size_t WS_BIASV = 198 * MiB;
constexpr size_t WS_BIG = 200 * MiB;
constexpr size_t BCU_OFF = 176 * MiB;
constexpr size_t FIN_BYTES = (size_t)2 * FF * DM * 2, FOUT_BYTES = (size_t)DM * FF * 2;

constexpr size_t WS_BAR = 1 * MiB + 256 * 1024;
constexpr int LDS_BYTES = 147456;

struct Args { const float* in[14]; float* out; unsigned char* ws; int nchunk; int flags; };

__device__ __forceinline__ float wave_sum(float v) {
#pragma unroll
    for (int o = 1; o < 64; o <<= 1) v += __shfl_xor(v, o);
    return v;
}

__device__ __forceinline__ void p0_transpose_item(const float* W, int K, int N, bf16_t* WT, int k0, int n0, int drow0, LAS float* scr, int lane) {
    float wv[32];
    GAS const float* wsrc = (GAS const float*)W + (size_t)(k0 + (lane >> 5)) * N + n0 + (lane & 31);
#pragma unroll
    for (int i = 0; i < 32; ++i) wv[i] = wsrc[(size_t)(2 * i) * N];
#pragma unroll
    for (int i = 0; i < 32; ++i) scr[(2 * i + (lane >> 5)) * 33 + (lane & 31)] = wv[i];
    asm volatile("s_waitcnt lgkmcnt(0)" ::: "memory");
    const int c = lane & 7;
#pragma unroll
    for (int j = 0; j < 4; ++j) { const int n = (lane >> 3) + 8 * j; const LAS float* s = scr + (8 * c) * 33 + n;
        u32x4 o; o.x = pk2(s[0 * 33], s[1 * 33]); o.y = pk2(s[2 * 33], s[3 * 33]); o.z = pk2(s[4 * 33], s[5 * 33]); o.w = pk2(s[6 * 33], s[7 * 33]);
        *(GAS u32x4*)((GAS bf16_t*)WT + (size_t)(drow0 + n) * K + k0 + 8 * c) = o; }
    asm volatile("s_waitcnt lgkmcnt(0)" ::: "memory");
}

__device__ __forceinline__ void norm_rows(const float* x_, const float* gvec_, const float* modl_, int sh_off, int sc_off, bf16_t* H_, int row_lo, int row_hi, int gw, int NGW, int lane) {
    GAS const float* x = opq(x_); GAS const float* gvec = opq(gvec_); GAS const float* modl = opq(modl_); GAS bf16_t* H = opq(H_); asm volatile("" : "+v"(lane));
    for (int row = row_lo + gw; row < row_hi; row += NGW) {
        const int b = row >> 11;
        GAS const f32x4* xr = (GAS const f32x4*)(x + (size_t)row * DM) + lane;
        f32x4 v[4]; float s = 0.f;
#pragma unroll
        for (int j = 0; j < 4; ++j) { v[j] = xr[64 * j]; s += (v[j].x * v[j].x + v[j].y * v[j].y) + (v[j].z * v[j].z + v[j].w * v[j].w); }
        const float rstd = __builtin_amdgcn_rsqf(wave_sum(s) * (1.f / DM) + EPS);
        GAS u32x2* o8 = (GAS u32x2*)(H + (size_t)row * DM) + lane;
        GAS const float* mb = modl + (size_t)b * MODW;
#pragma unroll
        for (int j = 0; j < 4; ++j) { const int col = 4 * lane + 256 * j;
            const f32x4 g4 = *(GAS const f32x4*)(gvec + col), sc4 = *(GAS const f32x4*)(mb + sc_off + col), sh4 = *(GAS const f32x4*)(mb + sh_off + col);
            const f32x4 o = (v[j] * rstd) * g4 * (sc4 + 1.0f) + sh4;
            u32x2 w; w.x = pk2(o.x, o.y); w.y = pk2(o.z, o.w); o8[64 * j] = w; }
    }
}

__device__ __forceinline__ void gemv16_item(GAS const float* vec, int vstride, bool do_silu, GAS const float* W, int N, int cb, GAS const float* bias, GAS float* outp, LAS unsigned char* lds, int tid, int wave, int lane) {
    LAS float* cs = (LAS float*)lds + wave * 2048;
    LAS float* red = (LAS float*)(lds + 65536);
    const int n = cb * 64 + lane;
#pragma unroll
    for (int b = 0; b < 16; ++b)
#pragma unroll
        for (int j = 0; j < 2; ++j) { const int kk = lane + 64 * j; const float v = vec[(size_t)b * vstride + 128 * wave + kk]; cs[b * 128 + kk] = do_silu ? v * __builtin_amdgcn_rcpf(1.f + __expf(-v)) : v; }
    float acc[16];
#pragma unroll
    for (int b = 0; b < 16; ++b) acc[b] = 0.f;
    GAS const float* wp = W + (size_t)(128 * wave) * N + n;
#pragma unroll 2
    for (int kk = 0; kk < 128; kk += 8) {
        float w[8];
#pragma unroll
        for (int e = 0; e < 8; ++e) w[e] = wp[(size_t)(kk + e) * N];
#pragma unroll
        for (int b = 0; b < 16; ++b) { const f32x4 c0 = *(const LAS f32x4*)(cs + b * 128 + kk), c1 = *(const LAS f32x4*)(cs + b * 128 + kk + 4);
            acc[b] += ((c0.x * w[0] + c0.y * w[1]) + (c0.z * w[2] + c0.w * w[3])) + ((c1.x * w[4] + c1.y * w[5]) + (c1.z * w[6] + c1.w * w[7])); }
    }
#pragma unroll
    for (int b = 0; b < 16; ++b) red[(wave * 16 + b) * 64 + lane] = acc[b];
    __syncthreads();
    for (int o = tid; o < 1024; o += 512) { const int b = o >> 6, l = o & 63; float s = 0.f;
#pragma unroll
        for (int w = 0; w < 8; ++w) s += red[(w * 16 + b) * 64 + l];
        const int nn = cb * 64 + l; outp[(size_t)b * N + nn] = s + (bias ? bias[nn] : 0.f); }
    __syncthreads();
}

__device__ __forceinline__ int crow(int reg, int h) { return (reg & 3) + 8 * (reg >> 2) + 4 * h; }
__device__ __forceinline__ void rope_cs(int pos, float (&cs)[8], float (&sn)[8]) {
    const float C[8] = {1.591549431e-01f, 3.086376340e-02f, 5.985185713e-03f, 1.160663641e-03f, 2.250790790e-04f, 4.364795279e-05f, 8.464330808e-06f, 1.641426263e-06f};
#pragma unroll
    for (int j = 0; j < 8; ++j) { const float rev = __builtin_amdgcn_fractf((float)pos * C[j]); cs[j] = __builtin_amdgcn_cosf(rev); sn[j] = __builtin_amdgcn_sinf(rev); }
}
__device__ __forceinline__ bf16x8 rope_frag(bf16x8 f, int pos, int hh) {
    u32x4 own = __builtin_bit_cast(u32x4, f), oth;
#pragma unroll
    for (int i = 0; i < 4; ++i) oth[i] = (unsigned)__shfl_xor((int)own[i], 32);
    float cs[8], sn[8]; rope_cs(pos, cs, sn);
    const float sg = hh ? 1.f : -1.f;
    u32x4 r;
#pragma unroll
    for (int i = 0; i < 4; ++i) {
        const float lo = bf_lo(own[i]) * cs[2 * i] + sg * bf_lo(oth[i]) * sn[2 * i];
        const float hi = bf_hi(own[i]) * cs[2 * i + 1] + sg * bf_hi(oth[i]) * sn[2 * i + 1];
        r[i] = pk2(lo, hi);
    }
    return __builtin_bit_cast(bf16x8, r);
}
#define MFMA32(a, b, c) __builtin_amdgcn_mfma_f32_32x32x16_bf16((a), (b), (c), 0, 0, 0)

constexpr int AT_KT = 4608, AT_VOFF = 12 * AT_KT, AT_VT = 4096, AT_OST = AT_VOFF + 12 * AT_VT, AT_OSTW = 32 * 144;
struct AttnPre { u32x4 ka[3], kb[3]; bf16x8 qf[4]; };
struct AttnGeo { int h, g, bl, dil, L, tsh, T0, ntile, ur, up0; };
__device__ __forceinline__ AttnGeo attn_geo(int U) {
    AttnGeo a; const int t8 = U & 7, rest = U >> 7; a.h = (U >> 3) & 15; a.g = rest % 3; a.bl = rest / 3;
    const int sh = 2 * a.g; a.dil = 1 << sh; a.L = SEQ >> sh; a.tsh = 6 - sh; a.T0 = t8 * 8; a.ntile = a.g < 2 ? 12 : 8;
    a.ur = a.T0 >> a.tsh; a.up0 = 32 * (a.T0 & ((1 << a.tsh) - 1)) - 64; return a;
}
__device__ __forceinline__ void attn_prefetch(GAS const bf16_t* qkv, int U, int tid, int wave, int lane, AttnPre& R) {
    const AttnGeo a = attn_geo(U);
    GAS const bf16_t* base = qkv + (size_t)a.bl * SEQ * NQKV + a.g * 3072 + a.h * 64;
#pragma unroll
    for (int k = 0; k < 3; ++k) {
        const int i = tid + 512 * k, j = i >> 7;
        const int rj = a.g < 2 ? a.ur : (a.T0 >> 2) + (j >> 2), pj = a.g < 2 ? a.up0 + 32 * j : 32 * (j & 3);
        const bool valid = j < a.ntile && pj >= 0 && pj < a.L;
        const int row = (i & 127) >> 2, pr = i & 3, tok = valid ? (pj + row) * a.dil + rj : 0;
        GAS const bf16_t* src = base + 1024 + (size_t)tok * NQKV + pr * 16;
        R.ka[k] = *(GAS const u32x4*)src; R.kb[k] = *(GAS const u32x4*)(src + 8);
    }
    const int r32 = lane & 31, hh = lane >> 5, Tw = a.T0 + wave, rw = Tw >> a.tsh, q0 = 32 * (Tw & ((1 << a.tsh) - 1));
    GAS const bf16_t* qrow = base + (size_t)((q0 + r32) * a.dil + rw) * NQKV;
#pragma unroll
    for (int ds = 0; ds < 4; ++ds) R.qf[ds] = *(GAS const bf16x8*)(qrow + 16 * ds + 8 * hh);
}
__device__ __forceinline__ void attn_unit(GAS bf16_t* qkv, GAS float* lse, LAS unsigned char* lds, int U, int Unext, int tid, int wave, int lane, AttnPre& R) {
    asm volatile("" : "+v"(lane));
    const AttnGeo a = attn_geo(U);
    const int g = a.g, h = a.h, bl = a.bl, dil = a.dil, L = a.L, tsh = a.tsh, T0 = a.T0, ntile = a.ntile, ur = a.ur, up0 = a.up0;
    GAS bf16_t* base = qkv + (size_t)bl * SEQ * NQKV + g * 3072 + h * 64;
    const int r32 = lane & 31, hh = lane >> 5;
    const int Tw = T0 + wave, rw = Tw >> tsh, q0 = 32 * (Tw & ((1 << tsh) - 1));
    const int tq = (q0 + r32) * dil + rw;
    GAS bf16_t* qrow = base + (size_t)tq * NQKV;
#pragma unroll
    for (int k = 0; k < 3; ++k) {
        const int i = tid + 512 * k, j = i >> 7;
        const int rj = g < 2 ? ur : (T0 >> 2) + (j >> 2), pj = g < 2 ? up0 + 32 * j : 32 * (j & 3);
        if (j < ntile && pj >= 0 && pj < L) {
            const int row = (i & 127) >> 2, pr = i & 3, tok = (pj + row) * dil + rj;
            u32x4 ka = R.ka[k], kb = R.kb[k];
            if (pr == 0) {
                float cs[8], sn[8]; rope_cs(tok, cs, sn);
#pragma unroll
                for (int e = 0; e < 4; ++e) {
                    const float x1l = bf_lo(ka[e]), x1h = bf_hi(ka[e]), x2l = bf_lo(kb[e]), x2h = bf_hi(kb[e]);
                    ka[e] = pk2(x1l * cs[2 * e] - x2l * sn[2 * e], x1h * cs[2 * e + 1] - x2h * sn[2 * e + 1]);
                    kb[e] = pk2(x2l * cs[2 * e] + x1l * sn[2 * e], x2h * cs[2 * e + 1] + x1h * sn[2 * e + 1]);
                }
            }
            LAS unsigned char* dst = lds + j * AT_KT + row * 144 + pr * 32;
            *(LAS u32x4*)dst = ka; *(LAS u32x4*)(dst + 16) = kb;
        }
    }
    bf16x8 qf[4];
#pragma unroll
    for (int ds = 0; ds < 4; ++ds) qf[ds] = R.qf[ds];
    qf[0] = rope_frag(qf[0], tq, hh);
    for (int i = wave; i < ntile * 4; i += 8) {
        const int j = i >> 2, dt = (i >> 1) & 1, kh = i & 1;
        const int rj = g < 2 ? ur : (T0 >> 2) + (j >> 2), pj = g < 2 ? up0 + 32 * j : 32 * (j & 3);
        if (pj >= 0 && pj < L) {
            const int key = pj + 16 * kh + (lane >> 2);
            GAS const bf16_t* src = base + 2048 + (size_t)(key * dil + rj) * NQKV + dt * 32 + (lane & 3) * 8;
            __builtin_amdgcn_global_load_lds((const unsigned*)src, (LAS unsigned*)(lds + AT_VOFF + j * AT_VT + dt * 2048 + kh * 1024), 16, 0, 0);
        }
    }
    asm volatile("" ::: "memory"); __builtin_amdgcn_sched_barrier(0);
    attn_prefetch(qkv, Unext, tid, wave, lane, R);
    asm volatile("s_waitcnt vmcnt(10) lgkmcnt(0)" ::: "memory");
    __builtin_amdgcn_s_barrier(); asm volatile("" ::: "memory");
    f32x16 sacc[5];
    const float NEG = -INFINITY;
#pragma unroll
    for (int kt = 0; kt < 5; ++kt) {
        const int kp0 = q0 - 64 + 32 * kt;
        if (kp0 >= 0 && kp0 < L) {
            const int j = g < 2 ? wave + kt : 4 * (wave >> 2) + (kp0 >> 5);
            const LAS unsigned char* kp = lds + j * AT_KT + r32 * 144 + hh * 16;
            f32x16 av;
#pragma unroll
            for (int i = 0; i < 16; ++i) av[i] = 0.f;
#pragma unroll
            for (int ds = 0; ds < 4; ++ds) av = MFMA32(*(const LAS bf16x8*)(kp + 32 * ds), qf[ds], av);
            if (kt == 0) {
#pragma unroll
                for (int i = 0; i < 16; ++i) if (crow(i, hh) < r32) av[i] = NEG;
            }
            if (kt == 4) {
#pragma unroll
                for (int i = 0; i < 16; ++i) if (crow(i, hh) > r32) av[i] = NEG;
            }
            sacc[kt] = av;
        } else {
#pragma unroll
            for (int i = 0; i < 16; ++i) sacc[kt][i] = NEG;
        }
    }
    float m = NEG;
#pragma unroll
    for (int kt = 0; kt < 5; ++kt)
#pragma unroll
        for (int i = 0; i < 16; ++i) m = fmaxf(m, sacc[kt][i]);
    m = fmaxf(m, __shfl_xor(m, 32));
    const float C = 0.125f * 1.44269504088896f, mC = m * C;
    float lsum = 0.f;
    bf16x8 pb[5][2];
#pragma unroll
    for (int kt = 0; kt < 5; ++kt) {
        float p[16];
#pragma unroll
        for (int i = 0; i < 16; ++i) { p[i] = __builtin_amdgcn_exp2f(sacc[kt][i] * C - mC); lsum += p[i]; }
#pragma unroll
        for (int s = 0; s < 2; ++s) { u32x4 w; w.x = pk2(p[8 * s], p[8 * s + 1]); w.y = pk2(p[8 * s + 2], p[8 * s + 3]); w.z = pk2(p[8 * s + 4], p[8 * s + 5]); w.w = pk2(p[8 * s + 6], p[8 * s + 7]);
            pb[kt][s] = __builtin_bit_cast(bf16x8, w); }
    }
    lsum += __shfl_xor(lsum, 32);
    f32x16 oacc[2];
#pragma unroll
    for (int dt = 0; dt < 2; ++dt)
#pragma unroll
        for (int i = 0; i < 16; ++i) oacc[dt][i] = 0.f;
    const int i16 = lane & 15, blk = (lane >> 4) & 1;
    const unsigned vb = (unsigned)((4 * hh + (i16 >> 2)) * 64 + 32 * blk + 8 * (i16 & 3));
#pragma unroll
    for (int kt = 0; kt < 5; ++kt) {
        const int kp0 = q0 - 64 + 32 * kt;
        if (kp0 >= 0 && kp0 < L) {
            const int j = g < 2 ? wave + kt : 4 * (wave >> 2) + (kp0 >> 5);
            LAS unsigned char* slot = lds + AT_VOFF + j * AT_VT + vb;
#pragma unroll
            for (int dt = 0; dt < 2; ++dt)
#pragma unroll
                for (int s = 0; s < 2; ++s) {
                    const s16x4 lo = __builtin_amdgcn_ds_read_tr16_b64_v4i16((LAS s16x4*)(slot + dt * 2048 + s * 1024));
                    const s16x4 hi = __builtin_amdgcn_ds_read_tr16_b64_v4i16((LAS s16x4*)(slot + dt * 2048 + s * 1024 + 512));
                    const bf16x8 va = __builtin_shufflevector(lo, hi, 0, 1, 2, 3, 4, 5, 6, 7);
                    oacc[dt] = MFMA32(va, pb[kt][s], oacc[dt]);
                }
        }
    }
    const float inv = 1.0f / lsum;
    LAS unsigned char* ost = lds + AT_OST + wave * AT_OSTW;
#pragma unroll
    for (int dt = 0; dt < 2; ++dt)
#pragma unroll
        for (int g4 = 0; g4 < 4; ++g4) {
            u32x2 w; w.x = pk2(oacc[dt][4 * g4] * inv, oacc[dt][4 * g4 + 1] * inv); w.y = pk2(oacc[dt][4 * g4 + 2] * inv, oacc[dt][4 * g4 + 3] * inv);
            *(LAS u32x2*)(ost + r32 * 144 + (32 * dt + 8 * g4 + 4 * hh) * 2) = w;
        }
    asm volatile("s_waitcnt lgkmcnt(0)" ::: "memory");
#pragma unroll
    for (int i = 0; i < 4; ++i) {
        const int row = (lane >> 3) + 8 * i, c = lane & 7;
        const u32x4 w = *(const LAS u32x4*)(ost + row * 144 + c * 16);
        *(GAS u32x4*)(base + (size_t)((q0 + row) * dil + rw) * NQKV + c * 8) = w;
    }
    if (hh == 0) lse[((size_t)bl * SEQ + tq) * 48 + g * 16 + h] = m * 0.125f + __logf(lsum);
    asm volatile("s_waitcnt lgkmcnt(0)" ::: "memory"); __builtin_amdgcn_s_barrier(); asm volatile("" ::: "memory");
}

#define XB_TMO      128
#define XB_XCNT(j)  (256  + 64 * (j))
#define XB_XSUB(j)  (1280 + 64 * (j))
#define XB_XGEN(j)  (2304 + 64 * (j))
#define XB_TOP      3328
#define XB_TOPGEN   3392
#define XCD_BAR_WORDS 3456
#define XB_SPIN_CAP (1u << 18)

__device__ __forceinline__ unsigned xb_ld(unsigned* p)              { return __hip_atomic_load(p, __ATOMIC_RELAXED, __HIP_MEMORY_SCOPE_AGENT); }
__device__ __forceinline__ unsigned xb_add(unsigned* p, unsigned v) { return __hip_atomic_fetch_add(p, v, __ATOMIC_RELAXED, __HIP_MEMORY_SCOPE_AGENT); }
__device__ __forceinline__ unsigned xb_xcc_id() { return (unsigned)__builtin_amdgcn_s_getreg((3 << 11) | 20) & 0xFu; }
#define XB_SPIN(cond, bar) do { unsigned _sp = 0; while (cond) { __builtin_amdgcn_s_sleep(1); \
    if ((++_sp & 255u) == 0u) { if (xb_ld(&(bar)[XB_TMO])) break; if (_sp > XB_SPIN_CAP) { atomicAdd(&(bar)[XB_TMO], 1u); break; } } } } while (0)

struct XcdBarrier {
    unsigned* bar; unsigned x;
    volatile LAS unsigned* st;
};

__device__ __forceinline__ XcdBarrier xcd_barrier_post(unsigned* bar, volatile LAS unsigned* st) {
    XcdBarrier b; b.bar = bar; b.x = xb_xcc_id(); b.st = st;
    if (threadIdx.x == 0) (void)xb_add(&bar[XB_XCNT(b.x)], 1u);
    return b;
}
__device__ __forceinline__ void xcd_barrier_complete(unsigned* bar, unsigned x, unsigned& nloc, unsigned& nx) {
    const unsigned G = gridDim.x * gridDim.y * gridDim.z;
    unsigned sum, cnt, mine, sp = 0u;
    for (;;) {
        sum = 0u; cnt = 0u; mine = 0u;
#pragma unroll
        for (unsigned j = 0; j < 16; ++j) { const unsigned c = xb_ld(&bar[XB_XCNT(j)]); sum += c; cnt += (c > 0u) ? 1u : 0u; mine = (j == x) ? c : mine; }
        if (sum == G) break;
        __builtin_amdgcn_s_sleep(1);
        if ((++sp & 255u) == 0u) { if (xb_ld(&bar[XB_TMO])) break; if (sp > XB_SPIN_CAP) { atomicAdd(&bar[XB_TMO], 1u); break; } }
    }
    nloc = mine > 0u ? mine : 1u; nx = cnt > 0u ? cnt : 1u;
}

__device__ __forceinline__ void xcd_barrier(const XcdBarrier& b) {
    asm volatile("s_waitcnt vmcnt(0)" ::: "memory");
    __syncthreads();
    if (threadIdx.x == 0) {
        unsigned* bar = b.bar;
        __builtin_amdgcn_s_waitcnt(0);
        unsigned nloc = b.st[0], nx = b.st[1];
        if (nloc == 0u) { xcd_barrier_complete(bar, b.x, nloc, nx); b.st[0] = nloc; b.st[1] = nx; }
        const unsigned old = xb_add(&bar[XB_XSUB(b.x)], 1u);
        const unsigned gen = old / nloc;
        if (old + 1u == (gen + 1u) * nloc) {
            __builtin_amdgcn_fence(__ATOMIC_RELEASE, "agent");
            asm volatile("s_waitcnt vmcnt(0)" ::: "memory");
            const unsigned og = xb_add(&bar[XB_TOP], 1u);
            const unsigned tg = og / nx;
            if (og + 1u == (tg + 1u) * nx) xb_add(&bar[XB_TOPGEN], 1u);
            else XB_SPIN(xb_ld(&bar[XB_TOPGEN]) == tg, bar);
            __builtin_amdgcn_fence(__ATOMIC_ACQUIRE, "agent");
            xb_add(&bar[XB_XGEN(b.x)], 1u);
            asm volatile("s_waitcnt vmcnt(0)" ::: "memory");
        } else {
            XB_SPIN(xb_ld(&bar[XB_XGEN(b.x)]) == gen, bar);
            __builtin_amdgcn_fence(__ATOMIC_ACQUIRE, "agent");
            asm volatile("s_waitcnt vmcnt(0)" ::: "memory");
        }
    }
    __syncthreads();
}

#define XL_ARR(x) (4096 + 64 * (x))
#define XL_GEN(x) (5120 + 64 * (x))
#define XL_WORDS 6144
__device__ __forceinline__ void xcd_local_barrier(unsigned* bar, unsigned x) {
    asm volatile("s_waitcnt vmcnt(0)" ::: "memory");
    __syncthreads();
    if (threadIdx.x == 0) {
        const unsigned old = xb_add(&bar[XL_ARR(x)], 1u), gen = old / 32u;
        if (old + 1u == (gen + 1u) * 32u) xb_add(&bar[XL_GEN(x)], 1u);
        else XB_SPIN(xb_ld(&bar[XL_GEN(x)]) == gen, bar);
        __builtin_amdgcn_fence(__ATOMIC_ACQUIRE, "agent");
        asm volatile("s_waitcnt vmcnt(0)" ::: "memory");
    }
    __syncthreads();
}

__global__ void __launch_bounds__(512, 2) mk_fwd(Args args) {
    extern __shared__ __attribute__((aligned(16))) unsigned char lds_raw[];
    LAS unsigned char* lds = (LAS unsigned char*)lds_raw;
    const int tid = threadIdx.x, lane = tid & 63, wave = __builtin_amdgcn_readfirstlane(tid >> 6);
    const int G = gridDim.x, bx = blockIdx.x, NGW = G * 8;
    int vbx = bx, gw = bx * 8 + wave;
    typedef const Args __attribute__((address_space(4))) CArgs;
#define AP() ({ CArgs* p_ = (CArgs*)__builtin_amdgcn_kernarg_segment_ptr(); asm volatile("" : "+s"(p_)); p_; })
#define x_in ((const float*)AP()->in[0])
#define c_in ((const float*)AP()->in[1])
#define w_qkv ((const float*)AP()->in[2])
#define w_o ((const float*)AP()->in[3])
#define w_cin ((const float*)AP()->in[4])
#define w_conv ((const float*)AP()->in[5])
#define w_cout ((const float*)AP()->in[6])
#define ada_w ((const float*)AP()->in[7])
#define ada_b ((const float*)AP()->in[8])
#define nmix_g ((const float*)AP()->in[9])
#define nffn_g ((const float*)AP()->in[10])
#define w_fin ((const float*)AP()->in[11])
#define w_fout ((const float*)AP()->in[12])
#define final_g ((const float*)AP()->in[13])
#define out ((float*)AP()->out)
#define ws ((unsigned char*)AP()->ws)
#define mod ((float*)(ws + WS_MOD))
#define rope ((float*)(ws + WS_ROPE))
#define Wqkv_t ((bf16_t*)(ws + WS_WQKV))
#define Wo_t ((bf16_t*)(ws + WS_WO))
#define Cin_t ((bf16_t*)(ws + WS_CIN))
#define Cout_t ((bf16_t*)(ws + WS_COUT))
#define H ((bf16_t*)(ws + WS_H))
#define O ((bf16_t*)(ws + WS_O))
#define LSE ((float*)(ws + WS_LSE))
#define BIG ((bf16_t*)(ws + WS_BIG))
#define BCU ((bf16_t*)(ws + WS_BIG + ((AP()->flags & 1) ? BCU_OFF : 0)))
#define ssq ((GAS float*)(ws + WS_SSQ))
#define bias_cin ((float*)(ws + WS_BIASV))
#define bias_fin (bias_cin + 16 * 3 * DM)
#define mod0 ((const float*)mod)
#define mod1 ((const float*)mod + 16 * MODW)
    const int nchunk = args.nchunk, MC = MTOK / nchunk;
    volatile LAS unsigned* bst = (volatile LAS unsigned*)(lds + LDS_BYTES - 16);
    unsigned* barw = (unsigned*)(ws + WS_BAR);
    if (tid < 2) bst[tid] = 0u;
    if (tid == 0) { const unsigned x_ = xb_xcc_id(); bst[3] = x_; bst[2] = xb_add(&barw[x_], 1u); }
    __syncthreads();
    const int xcc = __builtin_amdgcn_readfirstlane((int)bst[3]), xrank = __builtin_amdgcn_readfirstlane((int)bst[2]);
    const XcdBarrier xbar = xcd_barrier_post(barw, bst);

    {
        for (int item = bx; item < 192; item += G) { const int layer = item / 96, cb = item % 96;
            gemv16_item((GAS const float*)c_in, DM, true, (GAS const float*)ada_w + (size_t)layer * DM * MODW, MODW, cb, (GAS const float*)ada_b + layer * MODW, (GAS float*)mod + (size_t)layer * 16 * MODW, lds, tid, wave, lane); }
        __syncthreads();
        LAS float* scr = (LAS float*)(lds + wave * 16384);
        constexpr int I_QKV = 16 * 288, I_O = 16 * 32, I_CIN = 16 * 96, I_CO = 16 * 32, I_FIN = 16 * 176, I_FOUT = 44 * 32;
        constexpr int NITEMS = I_QKV + I_O + I_CIN + I_CO + 2 * I_FIN + 2 * I_FOUT;
        constexpr int POOL_A = 10600;
        const bool split = (G == 256);
        const int it0 = split ? (bx < 192 ? gw : POOL_A + (gw - 192 * 8)) : gw, itend = split ? (bx < 192 ? POOL_A : NITEMS) : NITEMS, itstep = split ? (bx < 192 ? 192 * 8 : 64 * 8) : NGW;
        for (int it = it0; it < itend; it += itstep) {
            int q = it;
            if (q < I_QKV) { const int kb = q / 288, nb = q % 288; p0_transpose_item(w_qkv, DM, NQKV, Wqkv_t, 64 * kb, 32 * nb, 32 * nb, scr, lane); continue; } q -= I_QKV;
            if (q < I_O) { const int kb = q / 32, nb = q % 32; p0_transpose_item(w_o, DM, DM, Wo_t, 64 * kb, 32 * nb, 32 * nb, scr, lane); continue; } q -= I_O;
            if (q < I_CIN) { const int kb = q / 96, nb = q % 96, n0 = 32 * nb;
                const int j0 = n0 < DM ? n0 : (n0 < 2 * DM ? n0 - DM : n0 - 2 * DM); const int drow = n0 < DM ? n0 : DM + 256 * (j0 >> 7) + (n0 < 2 * DM ? 0 : 128) + (j0 & 127);
                p0_transpose_item(w_cin, DM, 3 * DM, Cin_t, 64 * kb, n0, drow, scr, lane); continue; } q -= I_CIN;
            if (q < I_CO) { const int kb = q / 32, nb = q % 32; p0_transpose_item(w_cout, DM, DM, Cout_t, 64 * kb, 32 * nb, 32 * nb, scr, lane); continue; } q -= I_CO;
            if (q < 2 * I_FIN) { const int l = q / I_FIN; q -= l * I_FIN; const int kb = q / 176, nb = q % 176; const int n0 = 32 * nb;
                const int j0 = n0 < FF ? n0 : n0 - FF; const int drow = 256 * (j0 >> 7) + (n0 < FF ? 0 : 128) + (j0 & 127);
                p0_transpose_item(w_fin + (size_t)l * DM * 2 * FF, DM, 2 * FF, (bf16_t*)(ws + WS_FIN + l * FIN_BYTES), 64 * kb, n0, drow, scr, lane); continue; } q -= 2 * I_FIN;
            { const int l = q / I_FOUT; q -= l * I_FOUT; const int kb = q / 32, nb = q % 32;
                p0_transpose_item(w_fout + (size_t)l * FF * DM, FF, DM, (bf16_t*)(ws + WS_FOUT + l * FOUT_BYTES), 64 * kb, 32 * nb, 32 * nb, scr, lane); }
        }
        for (int idx = bx * 512 + tid; idx < SEQ * 8; idx += G * 512) {
            const int pos = idx >> 3, j = idx & 7;
            const float inv = exp2f(-(float)j * 0.125f * 18.931568569324174f);
            const float ang = (float)pos * inv;
            double rev = (double)ang * 0.15915494309189535; rev -= floor(rev);
            const float f = (float)rev;
            rope[pos * 16 + j] = __builtin_amdgcn_cosf(f); rope[pos * 16 + 8 + j] = __builtin_amdgcn_sinf(f);
        }
        __syncthreads();
        for (int i = bx * 512 + tid; i < 4 * MTOK; i += G * 512) ssq[i] = 0.f;
    }
    xcd_barrier(xbar);
    bool local = (AP()->flags & 1) && G == 256 && nchunk <= 2;
    { unsigned okc = 0;
#pragma unroll
      for (int j = 0; j < 8; ++j) okc += (xb_ld(&barw[j]) == 32u) ? 1u : 0u;
      local = local && (__builtin_amdgcn_readfirstlane((int)okc) == 8) && xcc < 8 && xrank < 32; }
    if (local) { vbx = xrank * 8 + xcc; gw = vbx * 8 + wave; }
    const int xl = vbx & 7, rk8 = (vbx >> 3) * 8 + wave;
#define SEAM() do { if (local) xcd_local_barrier(barw, (unsigned)xcc); else xcd_barrier(xbar); } while (0)
#define XLOOP(i, total) for (int i = local ? xl * ((total) / 8) + rk8 : gw, i##_e = local ? (xl + 1) * ((total) / 8) : (total), i##_s = local ? 256 : NGW; i < i##_e; i += i##_s)

    {
        for (int item = bx; item < 224; item += G) {
            if (item < 48) gemv16_item((GAS const float*)mod1, MODW, false, (GAS const float*)w_cin, 3 * DM, item, nullptr, (GAS float*)bias_cin, lds, tid, wave, lane);
            else { const int l = (item - 48) / 88, cb = (item - 48) % 88;
                gemv16_item((GAS const float*)(l ? mod1 : mod0) + 3 * DM, MODW, false, (GAS const float*)w_fin + (size_t)l * DM * 2 * FF, 2 * FF, cb, nullptr, (GAS float*)bias_fin + (size_t)l * 16 * 2 * FF, lds, tid, wave, lane); }
        }
    }
    if (local) norm_rows(x_in, nmix_g, mod0, 0, DM, H, xl * (MTOK / 8), (xl + 1) * (MTOK / 8), rk8, 256, lane);
    else norm_rows(x_in, nmix_g, mod0, 0, DM, H, 0, MTOK, gw, NGW, lane);
    SEAM();
    for (int ch = 0; ch < nchunk; ++ch) {
        const int row0 = ch * MC, ilv = (nchunk == 2) ? 1 : 0;
        {
            pg8::Gemm g{ilv ? H : H + (size_t)row0 * DM, Wqkv_t, MC, NQKV, DM, ilv, ch}; pg8::StaticOrder S; S.init(MC, NQKV, G, vbx);
            pg8::EpiBf16 E{opq(BIG), NQKV, nullptr, nullptr, 0};
            pg8::gemm_phase<pg8::EpiBf16, pg8::StaticOrder>(lds, g, S, E);
        }
        SEAM();
        {
            const int nunits = (MC / SEQ) * 384;
            GAS bf16_t* qkvp = opq(BIG); GAS float* lsep = opq(LSE); GAS const float* ropep = opq((const float*)rope); int tl = tid; asm volatile("" : "+v"(tl));
            const int u0 = local ? xl * (nunits / 8) + (vbx >> 3) : vbx, ue = local ? (xl + 1) * (nunits / 8) : nunits, us = local ? 32 : G;
            if (u0 < ue) {
                AttnPre R; attn_prefetch(qkvp, u0, tl, wave, tl & 63, R);
                for (int U = u0; U < ue; U += us) attn_unit(qkvp, lsep, lds, U, U + us < ue ? U + us : U, tl, wave, tl & 63, R);
            }
            asm volatile("s_waitcnt vmcnt(0)" ::: "memory");
        }
        SEAM();
        {
            GAS const float* lsep = opq(LSE); GAS const bf16_t* qkvp = opq(BIG); GAS bf16_t* Op = opq(O); int ln = lane; asm volatile("" : "+v"(ln));
            XLOOP(tok, MC) {
                const int hd = ln >> 2;
                const float l0 = lsep[(size_t)tok * 48 + hd], l1 = lsep[(size_t)tok * 48 + 16 + hd], l2 = lsep[(size_t)tok * 48 + 32 + hd];
                const float mx = fmaxf(l0, fmaxf(l1, l2));
                float w0 = __expf(l0 - mx), w1 = __expf(l1 - mx), w2 = __expf(l2 - mx);
                const float inv = 1.0f / (w0 + w1 + w2); w0 *= inv; w1 *= inv; w2 *= inv;
                GAS const bf16_t* src = qkvp + (size_t)tok * NQKV + ln * 16;
                float acc[16];
#pragma unroll
                for (int i = 0; i < 16; ++i) acc[i] = 0.f;
#pragma unroll
                for (int gg = 0; gg < 3; ++gg) { const float wg = gg == 0 ? w0 : (gg == 1 ? w1 : w2);
                    const u32x4 a = *(GAS const u32x4*)(src + gg * 3072), b = *(GAS const u32x4*)(src + gg * 3072 + 8);
#pragma unroll
                    for (int i = 0; i < 4; ++i) { acc[2 * i] += wg * bf_lo(a[i]); acc[2 * i + 1] += wg * bf_hi(a[i]); acc[8 + 2 * i] += wg * bf_lo(b[i]); acc[9 + 2 * i] += wg * bf_hi(b[i]); } }
                u32x4 o0, o1;
#pragma unroll
                for (int i = 0; i < 4; ++i) { o0[i] = pk2(acc[2 * i], acc[2 * i + 1]); o1[i] = pk2(acc[8 + 2 * i], acc[9 + 2 * i]); }
                GAS bf16_t* dst = Op + (size_t)(ilv ? (((tok >> 11) * 2 + ch) << 11) + (tok & (SEQ - 1)) : row0 + tok) * DM + ln * 16;
                *(GAS u32x4*)dst = o0; *(GAS u32x4*)(dst + 8) = o1;
            }
        }
        SEAM();
        {
            pg8::Gemm g{ilv ? O : O + (size_t)row0 * DM, Wo_t, MC, DM, DM, ilv, ch}; pg8::StaticOrder S; S.init(MC, DM, G, vbx);
            pg8::EpiResid E{opq(x_in), nullptr, nullptr, opq(mod0 + 2 * DM), opq(nffn_g), opq(mod0 + 4 * DM), opq(H), ssq, row0 / 256, ilv, ch};
            pg8::gemm_phase<pg8::EpiResid, pg8::StaticOrder>(lds, g, S, E);
        }
        if (ch == nchunk - 1) xcd_barrier(xbar);
    }
    for (int layer = 0; layer < 2; ++layer) {
#define modl (layer ? mod1 : mod0)
        if (layer == 1) {
            {
                pg8::Gemm g{H, Cin_t, MTOK, 3 * DM, DM, 0, 0}; pg8::StaticOrder S; S.init(MTOK, 3 * DM, G, vbx);
                pg8::EpiConvIn E{opq(BCU), opq(BCU + (size_t)MTOK * DM), ssq + MTOK, opq((const float*)bias_cin)};
                pg8::gemm_phase<pg8::EpiConvIn, pg8::StaticOrder>(lds, g, S, E);
            }
            SEAM();
            {
                GAS const bf16_t* bgp = opq(BCU); GAS const bf16_t* cup = opq(BCU + (size_t)MTOK * DM); GAS bf16_t* Zp = opq(O); GAS const float* wcv = opq(w_conv); int ln = lane; asm volatile("" : "+v"(ln));
                XLOOP(item, (MTOK / 16) * 2) {
                    const int rb = item >> 1, col = (item & 1) * 512 + ln * 8, t0 = rb * 16;
                    float wk[3][8];
#pragma unroll
                    for (int k = 0; k < 3; ++k) { const f32x4 a = *(GAS const f32x4*)(wcv + k * DM + col), b = *(GAS const f32x4*)(wcv + k * DM + col + 4);
                        wk[k][0] = a.x; wk[k][1] = a.y; wk[k][2] = a.z; wk[k][3] = a.w; wk[k][4] = b.x; wk[k][5] = b.y; wk[k][6] = b.z; wk[k][7] = b.w; }
                    float prev[8], cur[8], nxt[8];
#define LOAD_CU(t, d) do { const u32x4 cu_ = *(GAS const u32x4*)(cup + (size_t)(t) * DM + col); \
                        _Pragma("unroll") for (int i_ = 0; i_ < 4; ++i_) { d[2 * i_] = bf_lo(cu_[i_]); d[2 * i_ + 1] = bf_hi(cu_[i_]); } } while (0)
                    if ((t0 & (SEQ - 1)) == 0) {
#pragma unroll
                        for (int i = 0; i < 8; ++i) prev[i] = 0.f;
                    } else LOAD_CU(t0 - 1, prev);
                    LOAD_CU(t0, cur);
#pragma unroll 4
                    for (int i = 0; i < 16; ++i) {
                        const int t = t0 + i;
                        if ((t & (SEQ - 1)) == SEQ - 1) {
#pragma unroll
                            for (int e2 = 0; e2 < 8; ++e2) nxt[e2] = 0.f;
                        } else LOAD_CU(t + 1, nxt);
                        const u32x4 bb = *(GAS const u32x4*)(bgp + (size_t)t * DM + col);
                        float z[8];
#pragma unroll
                        for (int e2 = 0; e2 < 8; ++e2) z[e2] = wk[0][e2] * prev[e2] + wk[1][e2] * cur[e2] + wk[2][e2] * nxt[e2];
                        u32x4 w;
#pragma unroll
                        for (int e2 = 0; e2 < 4; ++e2) w[e2] = pk2(bf_lo(bb[e2]) * z[2 * e2], bf_hi(bb[e2]) * z[2 * e2 + 1]);
                        *(GAS u32x4*)(Zp + (size_t)t * DM + col) = w;
#pragma unroll
                        for (int e2 = 0; e2 < 8; ++e2) { prev[e2] = cur[e2]; cur[e2] = nxt[e2]; }
                    }
#undef LOAD_CU
                }
            }
            SEAM();
            {
                pg8::Gemm g{O, Cout_t, MTOK, DM, DM, 0, 0}; pg8::StaticOrder S; S.init(MTOK, DM, G, vbx);
                pg8::EpiResid E{nullptr, opq(nmix_g + DM), opq(mod1 + DM), opq(modl + 2 * DM), opq(nffn_g + DM), opq(modl + 4 * DM), opq(H), ssq + 2 * MTOK, 0, 0, 0};
                pg8::gemm_phase<pg8::EpiResid, pg8::StaticOrder>(lds, g, S, E);
            }
            SEAM();
        }
        {
            pg8::Gemm g{H, (const bf16_t*)(ws + WS_FIN + layer * FIN_BYTES), MTOK, 2 * FF, DM, 0, 0}; pg8::StaticOrder S; S.init(MTOK, 2 * FF, G, vbx);
            pg8::EpiSwiGLU E{opq(BIG), FF, ssq + (layer ? 2 * MTOK : 0), opq((const float*)bias_fin + (size_t)layer * 16 * 2 * FF)};
            pg8::gemm_phase<pg8::EpiSwiGLU, pg8::StaticOrder>(lds, g, S, E);
        }
        SEAM();
        {
            pg8::Gemm g{BIG, (const bf16_t*)(ws + WS_FOUT + layer * FOUT_BYTES), MTOK, DM, FF, 0, 0}; pg8::StaticOrder S; S.init(MTOK, DM, G, vbx);
            pg8::EpiResid E{nullptr, opq(nffn_g + layer * DM), opq(modl + 4 * DM), opq(modl + 5 * DM), layer ? opq(final_g) : opq(nmix_g + DM), layer ? (GAS const float*)nullptr : opq(mod1 + DM), opq(H), ssq + (layer ? 3 * MTOK : MTOK), 0, 0, 0};
            pg8::gemm_phase<pg8::EpiResid, pg8::StaticOrder>(lds, g, S, E);
        }
        SEAM();
    }
    {
        GAS float* op = opq(out); GAS const bf16_t* hp = opq((const bf16_t*)H); GAS const float* sq = ssq + 3 * MTOK; int ln = lane; asm volatile("" : "+v"(ln));
        XLOOP(row, MTOK) {
            const float rstd = __builtin_amdgcn_rsqf(sq[row] * (1.f / DM) + EPS);
#pragma unroll
            for (int j = 0; j < 2; ++j) {
                const u32x4 h = *(GAS const u32x4*)(hp + (size_t)row * DM + 512 * j + 8 * ln);
                GAS f32x4* o = (GAS f32x4*)(op + (size_t)row * DM + 512 * j + 8 * ln);
                o[0] = (f32x4){bf_lo(h.x) * rstd, bf_hi(h.x) * rstd, bf_lo(h.y) * rstd, bf_hi(h.y) * rstd};
                o[1] = (f32x4){bf_lo(h.z) * rstd, bf_hi(h.z) * rstd, bf_lo(h.w) * rstd, bf_hi(h.w) * rstd};
            }
        }
    }
}

#undef AP
#undef x_in
#undef c_in
#undef w_qkv
#undef w_o
#undef w_cin
#undef w_conv
#undef w_cout
#undef ada_w
#undef ada_b
#undef nmix_g
#undef nffn_g
#undef w_fin
#undef w_fout
#undef final_g
#undef out
#undef ws
#undef mod
#undef rope
#undef Wqkv_t
#undef Wo_t
#undef Cin_t
#undef Cout_t
#undef H
#undef O
#undef LSE
#undef BIG
#undef BCU
#undef SEAM
#undef XLOOP
#undef ssq
#undef bias_cin
#undef bias_fin
#undef mod0
#undef mod1
#undef modl
extern "C" void kernel_launch(void* const* d_in, const int* in_sizes, int n_in, void* d_out, int out_size, void* d_ws, size_t ws_size, hipStream_t stream) {
    static int grid = 0; static int nchunk = 0; static int flags = 0;
    if (grid == 0) {
        int dev = 0, cus = 0, per_cu = 0;
        if (hipGetDevice(&dev) != hipSuccess || hipDeviceGetAttribute(&cus, hipDeviceAttributeMultiprocessorCount, dev) != hipSuccess) { fprintf(stderr, "kernel_launch: device query failed\n"); grid = -1; return; }
        if (hipFuncSetAttribute((const void*)mk_fwd, hipFuncAttributeMaxDynamicSharedMemorySize, LDS_BYTES) != hipSuccess) { fprintf(stderr, "kernel_launch: hipFuncSetAttribute failed\n"); grid = -1; return; }
        if (hipOccupancyMaxActiveBlocksPerMultiprocessor(&per_cu, (const void*)mk_fwd, 512, LDS_BYTES) != hipSuccess || per_cu < 1) { fprintf(stderr, "kernel_launch: occupancy query says %d blocks/CU\n", per_cu); (void)hipGetLastError(); grid = -1; return; }
        grid = cus;
        const size_t need1 = WS_BIG + (size_t)MTOK * NQKV * 2, need2 = WS_BIG + (size_t)(MTOK / 2) * NQKV * 2, need4 = WS_BIG + (size_t)MTOK * 3 * DM * 2;
        nchunk = ws_size >= need1 ? 1 : (ws_size >= need2 ? 2 : 4);
        flags = (ws_size >= WS_BIG + BCU_OFF + (size_t)2 * MTOK * DM * 2) ? 1 : 0;
        if (ws_size < need4) { fprintf(stderr, "kernel_launch: workspace too small (%zu < %zu)\n", ws_size, need4); grid = -1; return; }
    }
    if (grid < 0) return;
    Args a{};
    for (int i = 0; i < 14; ++i) a.in[i] = (const float*)d_in[i];
    a.out = (float*)d_out; a.ws = (unsigned char*)d_ws; a.nchunk = nchunk; a.flags = flags;
    if (hipMemsetAsync((char*)d_ws + WS_BAR, 0, XL_WORDS * 4, stream) != hipSuccess) { fprintf(stderr, "kernel_launch: memset of the barrier words failed\n"); return; }
    void* kargs[] = {&a};
    hipError_t e = hipLaunchCooperativeKernel((const void*)mk_fwd, dim3(grid), dim3(512), kargs, LDS_BYTES, stream);
    if (e != hipSuccess) fprintf(stderr, "kernel_launch: cooperative launch failed: %s (grid %d)\n", hipGetErrorString(e), grid);
}
```
